# Optimizing an MI355X kernel written in HIP

```python
import math
import jax, jax.numpy as jnp
from jax import lax
import numpy as np

D_MODEL = 1024
BATCH = 8
SEQ = 2048
DEPTH = 1
DEC_BATCH = 128
DEC_SEQ = 4
PAST_LEN = 16384
PAGE_SIZE = 128

A_HEADS = 8
A_KV_HEADS = 2
A_GROUP = A_HEADS // A_KV_HEADS
A_HEAD_DIM = 64
A_WIDTH = A_HEADS * A_HEAD_DIM
A_KV_WIDTH = A_KV_HEADS * A_HEAD_DIM
WINDOW = 128
ROT_DIM = A_HEAD_DIM // 4
ROPE_THETA = 500000.0
DN_HEADS = 4
DN_HEAD_DIM = 128
DN_WIDTH = DN_HEADS * DN_HEAD_DIM
DN_CONV = 4
DN_CHUNK = 64
DT_MIN = 1e-3
DT_MAX = 1e-1
X_HEADS = 4
X_HEAD_DIM = 128
X_WIDTH = X_HEADS * X_HEAD_DIM
N_MEM = 256
D_FF = 2816
FFN_CONV = 3
EPS = 1e-6

IN_SPLITS = (A_WIDTH, A_KV_WIDTH, A_KV_WIDTH,
             DN_WIDTH, DN_WIDTH, DN_WIDTH, DN_WIDTH,
             DN_HEADS, DN_HEADS,
             D_MODEL, D_MODEL)
IN_WIDTH = sum(IN_SPLITS)

kernel_name = "hybrid_swa_gdn_xmem_convffn_step"

F32 = jnp.float32


def rmsnorm(x, g):
    xf = x.astype(F32)
    y = xf * lax.rsqrt(jnp.mean(xf * xf, axis=-1, keepdims=True) + EPS)
    return (y * g.astype(F32)).astype(x.dtype)


def l2norm(t):
    tf = t.astype(F32)
    return tf * lax.rsqrt(jnp.sum(tf * tf, axis=-1, keepdims=True) + EPS)


def split_cols(z, sizes):
    idx = [int(i) for i in np.cumsum(sizes)[:-1]]
    return jnp.split(z, idx, axis=-1)


def rope_partial(x, pos):
    half = ROT_DIM // 2
    inv = ROPE_THETA ** (-2.0 * jnp.arange(half, dtype=F32) / ROT_DIM)
    ang = pos.astype(F32)[:, None] * inv[None, :]
    cos = jnp.cos(ang)[None, :, None, :]
    sin = jnp.sin(ang)[None, :, None, :]
    xr = x[..., :ROT_DIM].astype(F32)
    x1, x2 = xr[..., :half], xr[..., half:]
    rot = jnp.concatenate([x1 * cos - x2 * sin, x2 * cos + x1 * sin], axis=-1).astype(x.dtype)
    return jnp.concatenate([rot, x[..., ROT_DIM:]], axis=-1)


def causal_dwconv(x, buf, w):
    width = w.shape[0]
    L = x.shape[1]
    xp = jnp.concatenate([buf.astype(x.dtype), x], axis=1)
    y = sum(xp[:, j:j + L] * w[j] for j in range(width))
    return y, xp[:, L:]


def window_mask(qpos, kpos):
    d = qpos[..., :, None] - kpos[..., None, :]
    return (d >= 0) & (d < WINDOW) & (kpos[..., None, :] >= 0)


def sink_attention(q, k, v, sinks, mask):
    s = jnp.einsum("bnqkgd,bnskd->bnkgqs", q, k, preferred_element_type=F32) * (A_HEAD_DIM ** -0.5)
    s = jnp.where(mask[None, :, None, None], s, -jnp.inf)
    sink = sinks.astype(F32).reshape(A_KV_HEADS, A_GROUP)[None, None, :, :, None, None]
    m = jnp.maximum(jnp.max(s, axis=-1, keepdims=True), sink)
    p = jnp.exp(s - m)
    p = p / (jnp.sum(p, axis=-1, keepdims=True) + jnp.exp(sink - m))
    return jnp.einsum("bnkgqs,bnskd->bnqkgd", p.astype(v.dtype), v)


def swa_prompt(q, k, v, sinks):
    B, L = q.shape[:2]
    nb = L // WINDOW
    qb = q.reshape(B, nb, WINDOW, A_KV_HEADS, A_GROUP, A_HEAD_DIM)

    def band(t):
        tb = t.reshape(B, nb, WINDOW, A_KV_HEADS, A_HEAD_DIM)
        prev = jnp.concatenate([jnp.zeros_like(tb[:, :1]), tb[:, :-1]], axis=1)
        return jnp.concatenate([prev, tb], axis=2)

    blk = jnp.arange(nb, dtype=jnp.int32)[:, None] * WINDOW
    qpos = blk + jnp.arange(WINDOW, dtype=jnp.int32)[None]
    kpos = blk + jnp.arange(-WINDOW, WINDOW, dtype=jnp.int32)[None]
    o = sink_attention(qb, band(k), band(v), sinks, window_mask(qpos, kpos))
    return o.reshape(B, L, A_WIDTH)


def swa_sample(q, k, v, sinks, buf_k, buf_v, pos):
    B, T = q.shape[:2]
    wb = buf_k.shape[1]
    kk = jnp.concatenate([buf_k.astype(k.dtype), k], axis=1)
    vv = jnp.concatenate([buf_v.astype(v.dtype), v], axis=1)
    qpos = pos[None]
    kpos = (pos[0] - wb + jnp.arange(wb + T, dtype=jnp.int32))[None]
    o = sink_attention(q.reshape(B, 1, T, A_KV_HEADS, A_GROUP, A_HEAD_DIM), kk[:, None], vv[:, None],
                       sinks, window_mask(qpos, kpos))
    return o.reshape(B, T, A_WIDTH), kk[:, -wb:], vv[:, -wb:]


def gated_delta(q, k, v, g, beta, S0, chunk):
    B, L, H, _ = q.shape
    dv = v.shape[-1]
    N = L // chunk

    def to_chunks(t):
        t = t.astype(F32).reshape((B, N, chunk) + t.shape[2:])
        return jnp.swapaxes(t, 2, 3)

    qc, kc, vc, gc, bc = [to_chunks(t) for t in (q, k, v, g, beta)]
    gcum = jnp.cumsum(gc, axis=-1)
    tril = jnp.tril(jnp.ones((chunk, chunk), bool))
    strict = jnp.tril(jnp.ones((chunk, chunk), bool), -1)
    decay = jnp.exp(jnp.where(tril, gcum[..., :, None] - gcum[..., None, :], -jnp.inf))
    kb = kc * bc[..., None]
    A = jnp.where(strict, jnp.einsum("bnhid,bnhjd->bnhij", kb, kc) * decay, 0.0)
    eye = jnp.eye(chunk, dtype=F32)
    rhs = jnp.concatenate([vc * bc[..., None], kb * jnp.exp(gcum)[..., None]], axis=-1)
    sol = lax.linalg.triangular_solve(A + eye, rhs, left_side=True, lower=True)
    u, w = sol[..., :dv], sol[..., dv:]
    qk = jnp.where(tril, jnp.einsum("bnhid,bnhjd->bnhij", qc, kc) * decay, 0.0)
    q_dec = qc * jnp.exp(gcum)[..., None]
    k_dec = kc * jnp.exp(gcum[..., -1:] - gcum)[..., None]
    g_last = jnp.exp(gcum[..., -1])

    def step(S, xs):
        u_i, w_i, qd_i, kd_i, qk_i, gl_i = xs
        v_new = u_i - jnp.einsum("bhck,bhkv->bhcv", w_i, S)
        o = jnp.einsum("bhck,bhkv->bhcv", qd_i, S) + jnp.einsum("bhij,bhjv->bhiv", qk_i, v_new)
        S = S * gl_i[..., None, None] + jnp.einsum("bhck,bhcv->bhkv", kd_i, v_new)
        return S, o

    xs = tuple(jnp.moveaxis(t, 1, 0) for t in (u, w, q_dec, k_dec, qk, g_last))
    S, o = lax.scan(step, S0.astype(F32), xs)
    o = jnp.swapaxes(jnp.moveaxis(o, 0, 1), 2, 3).reshape(B, L, H, dv)
    return o, S


def memory_kv(mem, g, w):
    B, M, _ = mem.shape
    mk, mv = jnp.split(rmsnorm(mem, g) @ w, 2, axis=-1)
    return mk.reshape(B, M, X_HEADS, X_HEAD_DIM), mv.reshape(B, M, X_HEADS, X_HEAD_DIM)


def trunk_layer(x, pos, mem_k, mem_v, win, dn_buf, dn_state, ffn_buf, p, chunk):
    B, L, _ = x.shape
    xn = rmsnorm(x, p["norm_mix_g"])
    aq, ak, av, dq, dk, dvv, dz, da, db, ga, gb = split_cols(xn @ p["w_in"], IN_SPLITS)
    aq = rope_partial(aq.reshape(B, L, A_HEADS, A_HEAD_DIM), pos)
    ak = rope_partial(ak.reshape(B, L, A_KV_HEADS, A_HEAD_DIM), pos)
    av = av.reshape(B, L, A_KV_HEADS, A_HEAD_DIM)
    if win is None:
        ya = swa_prompt(aq, ak, av, p["sinks"])
        wb = min(WINDOW, L)
        new_wk, new_wv = ak[:, L - wb:], av[:, L - wb:]
    else:
        ya, new_wk, new_wv = swa_sample(aq, ak, av, p["sinks"], win[0], win[1], pos)
    qkv, new_dn_buf = causal_dwconv(jnp.concatenate([dq, dk, dvv], axis=-1), dn_buf, p["dn_conv_w"])
    dq, dk, dvv = jnp.split(jax.nn.silu(qkv), 3, axis=-1)
    heads = lambda t: t.reshape(B, L, DN_HEADS, DN_HEAD_DIM)
    qh = l2norm(heads(dq)) * (DN_HEAD_DIM ** -0.5)
    kh = l2norm(heads(dk))
    g = -jnp.exp(p["dn_a_log"].astype(F32)) * jax.nn.softplus(da.astype(F32) + p["dn_dt_bias"].astype(F32))
    beta = jax.nn.sigmoid(db.astype(F32))
    o, new_S = gated_delta(qh, kh, heads(dvv), g, beta, dn_state, chunk)
    o = rmsnorm(o.astype(x.dtype), p["dn_norm_g"]) * jax.nn.silu(heads(dz))
    yb = o.reshape(B, L, DN_WIDTH)
    mix = jax.nn.sigmoid(ga) * (ya @ p["w_br_a"]) + jax.nn.sigmoid(gb) * (yb @ p["w_br_b"])
    h = x + mix @ p["w_mix_out"]
    hq = (rmsnorm(h, p["norm_x_g"]) @ p["w_xq"]).reshape(B, L, X_HEADS, X_HEAD_DIM)
    s = jnp.einsum("blhd,bmhd->bhlm", hq, mem_k.astype(hq.dtype), preferred_element_type=F32) * (X_HEAD_DIM ** -0.5)
    pr = jax.nn.softmax(s, axis=-1).astype(hq.dtype)
    xo = jnp.einsum("bhlm,bmhd->blhd", pr, mem_v.astype(hq.dtype)).reshape(B, L, X_WIDTH)
    h = h + xo @ p["w_xo"]
    u, gv = jnp.split(rmsnorm(h, p["norm_ffn_g"]) @ p["w_up"], 2, axis=-1)
    u, new_ffn_buf = causal_dwconv(u, ffn_buf, p["ffn_conv_w"])
    h = h + (jax.nn.silu(u) * gv) @ p["w_down"]
    return h, (new_wk, new_wv, new_dn_buf, new_S.astype(x.dtype), new_ffn_buf)


def setup_inputs(seed: int = 0) -> dict:
    key = jax.random.key(seed)
    ks = iter(jax.random.split(key, 40))
    nrm = lambda shape, scale=1.0: jax.random.normal(next(ks), shape, F32) * scale
    gain = lambda shape: 1.0 + 0.02 * jax.random.normal(next(ks), shape, F32)
    wb = min(WINDOW, PAST_LEN)
    u = jax.random.uniform(next(ks), (DEPTH, DN_HEADS), F32)
    dt = jnp.exp(u * (math.log(DT_MAX) - math.log(DT_MIN)) + math.log(DT_MIN))
    dn_dt_bias = dt + jnp.log(-jnp.expm1(-dt))
    dn_a_log = jnp.log(jax.random.uniform(next(ks), (DEPTH, DN_HEADS), F32, minval=1.0, maxval=16.0))
    return {
        "x_prompt": nrm((BATCH, SEQ, D_MODEL)),
        "x_sample": nrm((DEC_BATCH, DEC_SEQ, D_MODEL)),
        "mem_prompt": nrm((BATCH, N_MEM, D_MODEL)),
        "cache_win_k": nrm((DEPTH, DEC_BATCH, wb, A_KV_HEADS, A_HEAD_DIM)),
        "cache_win_v": nrm((DEPTH, DEC_BATCH, wb, A_KV_HEADS, A_HEAD_DIM)),
        "state_dn_conv": nrm((DEPTH, DEC_BATCH, DN_CONV - 1, 3 * DN_WIDTH)),
        "state_dn": nrm((DEPTH, DEC_BATCH, DN_HEADS, DN_HEAD_DIM, DN_HEAD_DIM), DN_HEAD_DIM ** -0.5),
        "cache_mem_k": nrm((DEPTH, DEC_BATCH, N_MEM, X_HEADS, X_HEAD_DIM)),
        "cache_mem_v": nrm((DEPTH, DEC_BATCH, N_MEM, X_HEADS, X_HEAD_DIM)),
        "state_ffn_conv": nrm((DEPTH, DEC_BATCH, FFN_CONV - 1, D_FF)),
        "norm_mix_g": gain((DEPTH, D_MODEL)),
        "w_in": nrm((DEPTH, D_MODEL, IN_WIDTH), D_MODEL ** -0.5),
        "dn_conv_w": nrm((DEPTH, DN_CONV, 3 * DN_WIDTH), DN_CONV ** -0.5),
        "dn_a_log": dn_a_log,
        "dn_dt_bias": dn_dt_bias,
        "dn_norm_g": gain((DEPTH, DN_HEAD_DIM)),
        "attn_sinks": nrm((DEPTH, A_HEADS), 0.5),
        "w_br_a": nrm((DEPTH, A_WIDTH, D_MODEL), A_WIDTH ** -0.5),
        "w_br_b": nrm((DEPTH, DN_WIDTH, D_MODEL), DN_WIDTH ** -0.5),
        "w_mix_out": nrm((DEPTH, D_MODEL, D_MODEL), D_MODEL ** -0.5),
        "norm_x_g": gain((DEPTH, D_MODEL)),
        "norm_mem_g": gain((DEPTH, D_MODEL)),
        "w_xq": nrm((DEPTH, D_MODEL, X_WIDTH), D_MODEL ** -0.5),
        "w_xkv": nrm((DEPTH, D_MODEL, 2 * X_WIDTH), D_MODEL ** -0.5),
        "w_xo": nrm((DEPTH, X_WIDTH, D_MODEL), X_WIDTH ** -0.5),
        "norm_ffn_g": gain((DEPTH, D_MODEL)),
        "w_up": nrm((DEPTH, D_MODEL, 2 * D_FF), D_MODEL ** -0.5),
        "ffn_conv_w": nrm((DEPTH, FFN_CONV, D_FF), FFN_CONV ** -0.5),
        "w_down": nrm((DEPTH, D_FF, D_MODEL), D_FF ** -0.5),
        "final_norm_g": gain((D_MODEL,)),
    }


def reference(x_prompt, x_sample, mem_prompt, cache_win_k, cache_win_v, state_dn_conv, state_dn,
              cache_mem_k, cache_mem_v, state_ffn_conv, norm_mix_g, w_in, dn_conv_w, dn_a_log,
              dn_dt_bias, dn_norm_g, attn_sinks, w_br_a, w_br_b, w_mix_out, norm_x_g, norm_mem_g,
              w_xq, w_xkv, w_xo, norm_ffn_g, w_up, ffn_conv_w, w_down, final_norm_g):
    Bp, Lp, _ = x_prompt.shape
    Ls = x_sample.shape[1]
    pos_p = jnp.arange(Lp, dtype=jnp.int32)
    pos_s = PAST_LEN + jnp.arange(Ls, dtype=jnp.int32)
    dt = x_prompt.dtype
    hp, hs = x_prompt, x_sample
    new_p = [[] for _ in range(5)]
    new_s = [[] for _ in range(5)]
    mem_k_list, mem_v_list = [], []
    for l in range(DEPTH):
        p = {"norm_mix_g": norm_mix_g[l], "w_in": w_in[l], "dn_conv_w": dn_conv_w[l],
             "dn_a_log": dn_a_log[l], "dn_dt_bias": dn_dt_bias[l], "dn_norm_g": dn_norm_g[l],
             "sinks": attn_sinks[l], "w_br_a": w_br_a[l], "w_br_b": w_br_b[l],
             "w_mix_out": w_mix_out[l], "norm_x_g": norm_x_g[l], "w_xq": w_xq[l], "w_xo": w_xo[l],
             "norm_ffn_g": norm_ffn_g[l], "w_up": w_up[l], "ffn_conv_w": ffn_conv_w[l],
             "w_down": w_down[l]}
        mk, mv = memory_kv(mem_prompt, norm_mem_g[l], w_xkv[l])
        hp, sp = trunk_layer(hp, pos_p, mk, mv, None,
                             jnp.zeros((Bp, DN_CONV - 1, 3 * DN_WIDTH), dt),
                             jnp.zeros((Bp, DN_HEADS, DN_HEAD_DIM, DN_HEAD_DIM), dt),
                             jnp.zeros((Bp, FFN_CONV - 1, D_FF), dt), p, min(DN_CHUNK, Lp))
        hs, ss = trunk_layer(hs, pos_s, cache_mem_k[l], cache_mem_v[l], (cache_win_k[l], cache_win_v[l]),
                             state_dn_conv[l], state_dn[l], state_ffn_conv[l], p, Ls)
        for lst, t in zip(new_p, sp):
            lst.append(t)
        for lst, t in zip(new_s, ss):
            lst.append(t)
        mem_k_list.append(mk)
        mem_v_list.append(mv)
    y_prompt = rmsnorm(hp, final_norm_g)
    y_sample = rmsnorm(hs, final_norm_g)
    p_win_k, p_win_v, p_dn_conv, p_dn_state, p_ffn_conv = [jnp.stack(t) for t in new_p]
    s_win_k, s_win_v, s_dn_conv, s_dn_state, s_ffn_conv = [jnp.stack(t) for t in new_s]
    p_mem_k = jnp.stack(mem_k_list)
    p_mem_v = jnp.stack(mem_v_list)
    return (y_prompt, y_sample, p_win_k, p_win_v, p_dn_conv, p_dn_state, p_mem_k, p_mem_v, p_ffn_conv,
            s_win_k, s_win_v, s_dn_conv, s_dn_state, s_ffn_conv)
```

```cpp
#include <hip/hip_runtime.h>
#include <hip/hip_cooperative_groups.h>
#include <cstdio>
#include <cstdint>
#include <cmath>
namespace cg = cooperative_groups;

namespace pg8 {
#define PG8_LAS __attribute__((address_space(3)))
typedef unsigned short bf16_t;
typedef short bf16x8 __attribute__((ext_vector_type(8)));
typedef float f32x4 __attribute__((ext_vector_type(4)));
typedef unsigned u32x4 __attribute__((ext_vector_type(4)));
constexpr int BM = 256, BK = 64, HALF = 128, HTB = HALF * BK * 2  , STAGE_BYTES = 8 * HTB, NXCD = 8, WGM = 4;

__host__ __device__ __forceinline__ int lds_byte(int r, int c) { const int st = (r >> 4) * 2 + (c >> 5), rr = r & 15, cc = c & 31, ob = rr * 64 + cc * 2; return st * 1024 + (ob ^ (((ob >> 9) & 1) << 5)); }
__host__ __device__ __forceinline__ void stage_rc(int b, int& R, int& C) { const int st = b / 1024, sb = b % 1024, swz = sb ^ (((sb >> 9) & 1) << 5); R = (st >> 1) * 16 + swz / 64; C = (st & 1) * 32 + (swz % 64) / 2; }
__host__ __device__ __forceinline__ int perm32(int rho) { const int n = rho >> 4, i = rho & 15; return 8 * (i >> 2) + 4 * n + (i & 3); }

struct Unit { int pm, pn, k0; };
struct Gemm { const bf16_t* A; const bf16_t* Bt; int M, N, K, ld, ldb; };

struct StaticOrder {
    int nM, nN, nwg, G, c;
    __host__ __device__ void init(int M, int N, int G_, int c_) { nM = M / BM; nN = N / BM; nwg = nM * nN; G = G_; c = c_; }
    __host__ __device__ bool next(int i, Unit& u) const {
        const long L = (long)i * G + c; if (L >= nwg) return false;
        int wgid = (int)L; { const int q = nwg / NXCD, r = nwg % NXCD, xcd = wgid % NXCD, off = wgid / NXCD; wgid = (xcd < r ? xcd * (q + 1) : r * (q + 1) + (xcd - r) * q) + off; }
        const int nig = WGM * nN, gid = wgid / nig, fm = gid * WGM, gsz = (nM - fm) < WGM ? (nM - fm) : WGM;
        u.pm = fm + ((wgid % nig) % gsz); u.pn = (wgid % nig) / gsz; u.k0 = 0; return true;
    }
    __device__ __forceinline__ void a_ready(const Unit&) const {}
    __device__ __forceinline__ void done(const Unit&) const {}
};

template <int NSL, int KLEN, int PM0> struct SliceOrder {
    int c;
    __device__ __forceinline__ bool next(int i, Unit& u) const { if (i != 0 || c >= 8 * NSL) return false; const int u8 = c / NSL, sl = c % NSL;
        u.pm = __builtin_amdgcn_readfirstlane(PM0 + (u8 >> 2)); u.pn = __builtin_amdgcn_readfirstlane(u8 & 3); u.k0 = __builtin_amdgcn_readfirstlane(sl * KLEN); return true; }
    __device__ __forceinline__ void a_ready(const Unit&) const {}
    __device__ __forceinline__ void done(const Unit&) const {}
};
__device__ __forceinline__ unsigned cvt_pk_bf16(float lo, float hi) { unsigned r; asm volatile("v_cvt_pk_bf16_f32 %0, %1, %2" : "=v"(r) : "v"(lo), "v"(hi)); return r; }
typedef unsigned u32x2 __attribute__((ext_vector_type(2)));
struct EpiBf16 {
    static constexpr bool PERM = true, AFTER_DRAIN = false;
    bf16_t* O; int ldc;
    __device__ __forceinline__ void operator()(const f32x4 (&acc)[2][2][4][2], const Unit& u, int wr, int wc, int fr, int fq) const {
        const int row0 = u.pm * BM + wr * 64 + fr; const int col0 = u.pn * BM + wc * 32 + 8 * fq;
#pragma unroll
        for (int ai = 0; ai < 2; ++ai)
#pragma unroll
            for (int m = 0; m < 4; ++m) { bf16_t* rowp = O + (size_t)(row0 + ai * HALF + m * 16) * ldc + col0;
#pragma unroll
                for (int bj = 0; bj < 2; ++bj) { const f32x4 v0 = acc[ai][bj][m][0], v1 = acc[ai][bj][m][1];
                    u32x4 w; w.x = cvt_pk_bf16(v0[0], v0[1]); w.y = cvt_pk_bf16(v0[2], v0[3]); w.z = cvt_pk_bf16(v1[0], v1[1]); w.w = cvt_pk_bf16(v1[2], v1[3]);
                    *(u32x4*)(rowp + bj * HALF) = w; } }
    }
};
template <class F> struct EpiF8 {
    static constexpr bool PERM = true, AFTER_DRAIN = false;
    F f;
    __device__ __forceinline__ void operator()(const f32x4 (&acc)[2][2][4][2], const Unit& u, int wr, int wc, int fr, int fq) const {
        asm volatile("" : "+v"(fr), "+v"(fq));
#pragma unroll
        for (int ai = 0; ai < 2; ++ai)
#pragma unroll
            for (int m = 0; m < 4; ++m) { const int row = u.pm * BM + ai * HALF + wr * 64 + m * 16 + fr;
#pragma unroll
                for (int bj = 0; bj < 2; ++bj) f(row, u.pn * BM + bj * HALF + wc * 32 + 8 * fq, acc[ai][bj][m][0], acc[ai][bj][m][1]); }
    }
};
template <class F> struct EpiF8P {
    static constexpr bool PERM = true, AFTER_DRAIN = false;
    F f;
    __device__ __forceinline__ void operator()(const f32x4 (&acc)[2][2][4][2], const Unit& u, int wr, int wc, int fr, int fq) const {
        asm volatile("" : "+v"(fr), "+v"(fq));
        const int col0 = u.pn * BM + wc * 32 + 8 * fq;
#pragma unroll
        for (int ai = 0; ai < 2; ++ai)
#pragma unroll
        for (int mh = 0; mh < 2; ++mh) {
            const int row0 = u.pm * BM + ai * HALF + wr * 64 + mh * 32 + fr;
            typename F::L ld[2][2];
#pragma unroll
            for (int m = 0; m < 2; ++m)
#pragma unroll
                for (int bj = 0; bj < 2; ++bj) ld[m][bj] = f.load(row0 + m * 16, col0 + bj * HALF);
#pragma unroll
            for (int m = 0; m < 2; ++m)
#pragma unroll
                for (int bj = 0; bj < 2; ++bj) f.apply(row0 + m * 16, col0 + bj * HALF, acc[ai][bj][2 * mh + m][0], acc[ai][bj][2 * mh + m][1], ld[m][bj]);
        }
    }
};
template <class F> struct EpiF {
    static constexpr bool PERM = false, AFTER_DRAIN = false;
    F f;
    __device__ __forceinline__ void operator()(const f32x4 (&acc)[2][2][4][2], const Unit& u, int wr, int wc, int fr, int fq) const {
        asm volatile("" : "+v"(fr), "+v"(fq));
#pragma unroll
        for (int ai = 0; ai < 2; ++ai)
#pragma unroll
            for (int m = 0; m < 4; ++m) { const int row = u.pm * BM + ai * HALF + wr * 64 + m * 16 + fr;
#pragma unroll
                for (int bj = 0; bj < 2; ++bj)
#pragma unroll
                    for (int n = 0; n < 2; ++n) f(row, u.pn * BM + bj * HALF + wc * 32 + n * 16 + 4 * fq, acc[ai][bj][m][n]); }
    }
};
template <class Epi, class Sched, bool ALIGN_EPI = false, bool SP2 = false>
__device__ __forceinline__ void gemm_phase(PG8_LAS unsigned char* lds, const Gemm g, const Sched& S, const Epi& E) {
    const int tid = threadIdx.x, wid = __builtin_amdgcn_readfirstlane(tid >> 6), lane = tid & 63, wr = wid >> 2, wc = wid & 3, fr = lane & 15, fq = lane >> 4;
    const int K = g.ld, KB = g.ldb ? g.ldb : g.ld, nt = g.K / BK;
    unsigned voffA, voffB;
    { int R, C; stage_rc(tid * 16, R, C); const int Rb = Epi::PERM ? ((R & ~31) + perm32(R & 31)) : R;
      voffA = (unsigned)(R * K + C) * 2u; voffB = (unsigned)(Rb * KB + C) * 2u; }
    const size_t rstep64A = (size_t)64 * K * 2, rstep64B = (size_t)64 * KB * 2;
    const size_t kstep = (size_t)(BK * 2);
    const size_t hstepA = (size_t)HALF * K * 2, hstepB = (size_t)HALF * KB * 2;
    const size_t tstepA = 2 * hstepA, tstepB = 2 * hstepB;
    const unsigned ldsw = (unsigned)wid * 1024u;
    const int aoff = lds_byte(wr * 64 + fr, fq * 8), boff = lds_byte(wc * 32 + fr, fq * 8);
#define PG8_SA(b, h) (((b) * 2 + (h)) * HTB)
#define PG8_SB(b, h) ((4 + (b) * 2 + (h)) * HTB)
#define PG8_STAGE(bufoff, gbase, voff, rstep64) do { _Pragma("unroll") for (int _i = 0; _i < 2; ++_i) \
        __builtin_amdgcn_global_load_lds((const unsigned*)((const char*)(gbase) + (size_t)_i * rstep64 + (voff)), (PG8_LAS unsigned*)(lds + (bufoff) + ldsw + _i * 8192), 16, 0, 0); } while (0)
#define PG8_LDA(dst, b, h) do { _Pragma("unroll") for (int m = 0; m < 4; ++m) _Pragma("unroll") for (int k = 0; k < 2; ++k) dst[m][k] = *(const PG8_LAS bf16x8*)(lds + PG8_SA(b, h) + aoff + m * 2048 + k * 1024); } while (0)
#define PG8_LDB(dst, b, h) do { _Pragma("unroll") for (int n = 0; n < 2; ++n) _Pragma("unroll") for (int k = 0; k < 2; ++k) dst[n][k] = *(const PG8_LAS bf16x8*)(lds + PG8_SB(b, h) + boff + n * 2048 + k * 1024); } while (0)
#define PG8_MMA(ai, bj, At, Bt) do { __builtin_amdgcn_s_setprio(1); _Pragma("unroll") for (int m = 0; m < 4; ++m) _Pragma("unroll") for (int n = 0; n < 2; ++n) _Pragma("unroll") for (int k = 0; k < 2; ++k) \
        acc[ai][bj][m][n] = __builtin_amdgcn_mfma_f32_16x16x32_bf16(Bt[n][k], At[m][k], acc[ai][bj][m][n], 0, 0, 0); __builtin_amdgcn_s_setprio(0); } while (0)
#define PG8_WAIT_V(n) asm volatile("s_waitcnt vmcnt(" #n ")" ::: "memory")
#define PG8_WAIT_L(n) asm volatile("s_waitcnt lgkmcnt(" #n ")" ::: "memory")
#define PG8_BAR __builtin_amdgcn_s_barrier()
#define PG8_SCHED __builtin_amdgcn_sched_barrier(0)
    Unit cur, nxt; int ui = 0;
    if (!S.next(0, cur)) return;
    f32x4 acc[2][2][4][2];
#pragma unroll
    for (int a = 0; a < 2; ++a)
#pragma unroll
        for (int b = 0; b < 2; ++b)
#pragma unroll
            for (int m = 0; m < 4; ++m)
#pragma unroll
                for (int n = 0; n < 2; ++n) acc[a][b][m][n] = (f32x4){0.f, 0.f, 0.f, 0.f};
    bf16x8 At[4][2], B0[2][2], B1[2][2];
    const char* cA = (const char*)g.A + (size_t)cur.pm * tstepA + (size_t)cur.k0 * 2; const char* cB = (const char*)g.Bt + (size_t)cur.pn * tstepB + (size_t)cur.k0 * 2;
    S.a_ready(cur);
    if constexpr (SP2) {
        PG8_STAGE(PG8_SB(0, 0), cB, voffB, rstep64B); PG8_STAGE(PG8_SB(0, 1), cB + hstepB, voffB, rstep64B); PG8_STAGE(PG8_SA(0, 0), cA, voffA, rstep64A); PG8_STAGE(PG8_SA(0, 1), cA + hstepA, voffA, rstep64A);
        if (wr == 1) PG8_BAR;
        PG8_WAIT_V(2); PG8_BAR;
        PG8_STAGE(PG8_SB(1, 0), cB + kstep, voffB, rstep64B); PG8_STAGE(PG8_SA(1, 0), cA + kstep, voffA, rstep64A); PG8_STAGE(PG8_SB(1, 1), cB + hstepB + kstep, voffB, rstep64B);
        PG8_WAIT_V(6); PG8_BAR;
    } else {
        PG8_STAGE(PG8_SB(0, 0), cB, voffB, rstep64B); PG8_STAGE(PG8_SA(0, 0), cA, voffA, rstep64A); PG8_STAGE(PG8_SB(0, 1), cB + hstepB, voffB, rstep64B); PG8_STAGE(PG8_SA(0, 1), cA + hstepA, voffA, rstep64A);
        if (wr == 1) PG8_BAR;
        PG8_WAIT_V(4); PG8_BAR;
        PG8_STAGE(PG8_SB(1, 0), cB + kstep, voffB, rstep64B); PG8_STAGE(PG8_SA(1, 0), cA + kstep, voffA, rstep64A); PG8_STAGE(PG8_SB(1, 1), cB + hstepB + kstep, voffB, rstep64B);
        PG8_WAIT_V(6); PG8_BAR;
    }
    for (;;) {
        const bool has_next = S.next(ui + 1, nxt);
        const char* nA = has_next ? (const char*)g.A + (size_t)nxt.pm * tstepA + (size_t)nxt.k0 * 2 : cA; const char* nB = has_next ? (const char*)g.Bt + (size_t)nxt.pn * tstepB + (size_t)nxt.k0 * 2 : cB;
        for (int t = 0; t < nt; t += 2) {
            const bool last = (t == nt - 2);
            const char* a1 = cA + (size_t)(t + 1) * kstep;
            const char* a2 = last ? nA : cA + (size_t)(t + 2) * kstep; const char* b2 = last ? nB : cB + (size_t)(t + 2) * kstep;
            const char* a3 = a2 + kstep; const char* b3 = b2 + kstep;
            if (last && has_next) S.a_ready(nxt);
            if constexpr (SP2) {
            PG8_LDB(B0, 0, 0); PG8_LDB(B1, 0, 1); PG8_SCHED; PG8_LDA(At, 0, 0); PG8_STAGE(PG8_SA(1, 1), a1 + hstepA, voffA, rstep64A);
            PG8_WAIT_V(8); PG8_WAIT_L(0); PG8_BAR; PG8_MMA(0, 0, At, B0); PG8_MMA(0, 1, At, B1); PG8_BAR; PG8_SCHED;
            PG8_LDA(At, 0, 1); PG8_STAGE(PG8_SB(0, 0), b2, voffB, rstep64B); PG8_STAGE(PG8_SB(0, 1), b2 + hstepB, voffB, rstep64B); PG8_STAGE(PG8_SA(0, 0), a2, voffA, rstep64A);
            PG8_WAIT_V(8); PG8_WAIT_L(0); PG8_BAR; PG8_MMA(1, 0, At, B0); PG8_MMA(1, 1, At, B1); PG8_BAR; PG8_SCHED;
            PG8_LDB(B0, 1, 0); PG8_LDB(B1, 1, 1); PG8_SCHED; PG8_LDA(At, 1, 0); PG8_STAGE(PG8_SA(0, 1), a2 + hstepA, voffA, rstep64A);
            PG8_WAIT_V(8); PG8_WAIT_L(0); PG8_BAR; PG8_MMA(0, 0, At, B0); PG8_MMA(0, 1, At, B1); PG8_BAR; PG8_SCHED;
            PG8_LDA(At, 1, 1); PG8_STAGE(PG8_SB(1, 0), b3, voffB, rstep64B); PG8_STAGE(PG8_SB(1, 1), b3 + hstepB, voffB, rstep64B); PG8_STAGE(PG8_SA(1, 0), a3, voffA, rstep64A);
            PG8_WAIT_V(8); PG8_WAIT_L(0); PG8_BAR; PG8_MMA(1, 0, At, B0); PG8_MMA(1, 1, At, B1); PG8_BAR; PG8_SCHED;
            } else {
            PG8_LDB(B0, 0, 0); PG8_SCHED; PG8_LDA(At, 0, 0); PG8_STAGE(PG8_SA(1, 1), a1 + hstepA, voffA, rstep64A);
            PG8_WAIT_L(8); PG8_BAR; PG8_WAIT_L(0); PG8_MMA(0, 0, At, B0); PG8_BAR; PG8_SCHED;
            PG8_LDB(B1, 0, 1); PG8_STAGE(PG8_SB(0, 0), b2, voffB, rstep64B);
            PG8_BAR; PG8_WAIT_L(0); PG8_MMA(0, 1, At, B1); PG8_BAR;
            PG8_LDA(At, 0, 1); PG8_STAGE(PG8_SA(0, 0), a2, voffA, rstep64A);
            PG8_BAR; PG8_WAIT_L(0); PG8_MMA(1, 0, At, B0); PG8_BAR; PG8_SCHED;
            PG8_STAGE(PG8_SB(0, 1), b2 + hstepB, voffB, rstep64B);
            PG8_WAIT_V(6); PG8_BAR; PG8_MMA(1, 1, At, B1); PG8_BAR;
            PG8_LDB(B0, 1, 0); PG8_SCHED; PG8_LDA(At, 1, 0); PG8_STAGE(PG8_SA(0, 1), a2 + hstepA, voffA, rstep64A);
            PG8_WAIT_L(8); PG8_BAR; PG8_WAIT_L(0); PG8_MMA(0, 0, At, B0); PG8_BAR; PG8_SCHED;
            PG8_LDB(B1, 1, 1); PG8_STAGE(PG8_SB(1, 0), b3, voffB, rstep64B);
            PG8_BAR; PG8_WAIT_L(0); PG8_MMA(0, 1, At, B1); PG8_BAR;
            PG8_LDA(At, 1, 1); PG8_STAGE(PG8_SA(1, 0), a3, voffA, rstep64A);
            PG8_BAR; PG8_WAIT_L(0); PG8_MMA(1, 0, At, B0); PG8_BAR; PG8_SCHED;
            PG8_STAGE(PG8_SB(1, 1), b3 + hstepB, voffB, rstep64B);
            PG8_WAIT_V(6); PG8_BAR; PG8_MMA(1, 1, At, B1); PG8_BAR;
            }
        }
        if constexpr (ALIGN_EPI) { if (wr == 0) PG8_BAR; }
        if constexpr (!Epi::AFTER_DRAIN) { E(acc, cur, wr, wc, fr, fq); S.done(cur); }
        if (!has_next) break;
#pragma unroll
        for (int a = 0; a < 2; ++a)
#pragma unroll
            for (int b = 0; b < 2; ++b)
#pragma unroll
                for (int m = 0; m < 4; ++m)
#pragma unroll
                    for (int n = 0; n < 2; ++n) acc[a][b][m][n] = (f32x4){0.f, 0.f, 0.f, 0.f};
        cur = nxt; cA = nA; cB = nB; ++ui;
        if constexpr (ALIGN_EPI) { if (wr == 1) PG8_BAR; }
    }
    PG8_WAIT_V(0);
    if constexpr (!ALIGN_EPI) { if (wr == 0) PG8_BAR; }
    PG8_BAR;
    if constexpr (Epi::AFTER_DRAIN) { E.fused(acc, cur, wr, wc, fr, fq, lds, wid, lane); S.done(cur); }
#undef PG8_SA
#undef PG8_SB
#undef PG8_STAGE
#undef PG8_LDA
#undef PG8_LDB
#undef PG8_MMA
#undef PG8_WAIT_V
#undef PG8_WAIT_L
#undef PG8_BAR
#undef PG8_SCHED
}
}

#define LAS __attribute__((address_space(3)))
typedef unsigned short bf16_t;
typedef short bf16x8 __attribute__((ext_vector_type(8)));
typedef short s16x4 __attribute__((ext_vector_type(4)));
typedef float f32x4 __attribute__((ext_vector_type(4)));
typedef float f32x2 __attribute__((ext_vector_type(2)));
typedef unsigned u32x4 __attribute__((ext_vector_type(4)));
typedef unsigned u32x2 __attribute__((ext_vector_type(2)));

constexpr int MP = 16384, MS = 512, MT = MP + MS;
constexpr int NZ = 4864;
constexpr int ZK = 512, ZV = 640, ZDQ = 768, ZDZ = 2304, ZGA = 2816, ZGB = 3840;
constexpr int NTHR = 512;
constexpr int LDS_BYTES = 163840;
constexpr float EPS = 1e-6f;

constexpr size_t O_Y = 0;
constexpr size_t O_PWK = (size_t)MT * 1024;
constexpr size_t O_PWV = O_PWK + 131072;
constexpr size_t O_PDC = O_PWV + 131072;
constexpr size_t O_PDS = O_PDC + 36864;
constexpr size_t O_PMK = O_PDS + 524288;
constexpr size_t O_PMV = O_PMK + 1048576;
constexpr size_t O_PFC = O_PMV + 1048576;
constexpr size_t O_SWK = O_PFC + 45056;
constexpr size_t O_SWV = O_SWK + 2097152;
constexpr size_t O_SDC = O_SWV + 2097152;
constexpr size_t O_SDS = O_SDC + 589824;
constexpr size_t O_SFC = O_SDS + 8388608;
constexpr size_t O_END = O_SFC + 720896;

constexpr size_t WS_WIN = 0;
constexpr size_t WS_WA = WS_WIN + (size_t)4864 * 1024 * 2;
constexpr size_t WS_WB = WS_WA + (size_t)1024 * 512 * 2;
constexpr size_t WS_WMO = WS_WB + (size_t)1024 * 512 * 2;
constexpr size_t WS_WXQ = WS_WMO + (size_t)1024 * 1024 * 2;
constexpr size_t WS_WXKV = WS_WXQ + (size_t)512 * 1024 * 2;
constexpr size_t WS_WXO = WS_WXKV + (size_t)1024 * 1024 * 2;
constexpr size_t WS_WUP = WS_WXO + (size_t)1024 * 512 * 2;
constexpr size_t WS_WDN = WS_WUP + (size_t)5632 * 1024 * 2;
constexpr size_t WS_RA = WS_WDN + (size_t)1024 * 2816 * 2;
constexpr size_t WS_Z = WS_RA + (size_t)MT * 1024 * 2;
constexpr size_t WS_YA = WS_Z + (size_t)MT * NZ * 2;
constexpr size_t WS_YB = WS_YA + (size_t)MT * 512 * 2;
constexpr size_t WS_MEMN = WS_YB + (size_t)MT * 512 * 2;
constexpr size_t WS_GB = WS_MEMN + (size_t)2048 * 1024 * 2;
constexpr size_t WS_ROPE = WS_GB + (size_t)MT * 8 * 4;
constexpr size_t WS_GLAST = WS_ROPE + (size_t)2052 * 16 * 4;
constexpr size_t WS_CTL = WS_GLAST + 4096;
constexpr size_t WS_END = WS_CTL + 16384;
constexpr size_t ZO_HQ = 0, ZO_XO = (size_t)MT * 512 * 2;
constexpr size_t ZO_UG = 0;
static_assert(ZO_UG + (size_t)MT * 5632 * 2 <= (size_t)MT * NZ * 2 + 2 * (size_t)MT * 512 * 2 && WS_YA == WS_Z + (size_t)MT * NZ * 2 && WS_YB == WS_YA + (size_t)MT * 512 * 2, "FFN overlay fits in Z|YA|YB");

struct Params { const float* in[30]; float* out; unsigned char* ws; double inv[8]; };

__device__ __forceinline__ unsigned f2bf(float f) { unsigned r; asm("v_cvt_pk_bf16_f32 %0, %1, %1" : "=v"(r) : "v"(f)); return r & 0xffffu; }
__device__ __forceinline__ unsigned pk2(float lo, float hi) { unsigned r; asm("v_cvt_pk_bf16_f32 %0, %1, %2" : "=v"(r) : "v"(lo), "v"(hi)); return r; }
__device__ __forceinline__ float bf2f(unsigned short b) { return __builtin_bit_cast(float, (unsigned)b << 16); }
__device__ __forceinline__ float bflo(unsigned w) { return __builtin_bit_cast(float, w << 16); }
__device__ __forceinline__ float bfhi(unsigned w) { return __builtin_bit_cast(float, w & 0xffff0000u); }
__device__ __forceinline__ float sigm(float x) { return __builtin_amdgcn_rcpf(1.f + __expf(-x)); }
__device__ __forceinline__ float silu(float x) { return x * __builtin_amdgcn_rcpf(1.f + __expf(-x)); }
__device__ __forceinline__ float wave_sum(float v) {
#pragma unroll
    for (int o = 1; o < 64; o <<= 1) v += __shfl_xor(v, o);
    return v;
}

#define LBAR() do { asm volatile("s_waitcnt lgkmcnt(0)" ::: "memory"); __builtin_amdgcn_s_barrier(); asm volatile("" ::: "memory"); } while (0)
struct FMem { float* pk; float* pv;
    __device__ __forceinline__ void operator()(int row, int col, const f32x4& v) const {
        float* d = (col < 512) ? (pk + (size_t)row * 512 + col) : (pv + (size_t)row * 512 + (col - 512)); *(f32x4*)d = v; } };
struct FGateA { const bf16_t* Z; float* t1;
    __device__ __forceinline__ void operator()(int row, int col, const f32x4& v) const {
        const u32x2 g = *(const u32x2*)(Z + (size_t)row * NZ + ZGA + col);
        f32x4 o; o[0] = sigm(bflo(g.x)) * v[0]; o[1] = sigm(bfhi(g.x)) * v[1]; o[2] = sigm(bflo(g.y)) * v[2]; o[3] = sigm(bfhi(g.y)) * v[3];
        *(f32x4*)(t1 + (size_t)row * 1024 + col) = o; } };
struct FGateB { const bf16_t* Z; const float* t1; bf16_t* mix;
    __device__ __forceinline__ void operator()(int row, int col, const f32x4& v) const {
        const u32x2 g = *(const u32x2*)(Z + (size_t)row * NZ + ZGB + col);
        const f32x4 t = *(const f32x4*)(t1 + (size_t)row * 1024 + col);
        u32x2 w; w.x = pk2(t[0] + sigm(bflo(g.x)) * v[0], t[1] + sigm(bfhi(g.x)) * v[1]); w.y = pk2(t[2] + sigm(bflo(g.y)) * v[2], t[3] + sigm(bfhi(g.y)) * v[3]);
        *(u32x2*)(mix + (size_t)row * 1024 + col) = w; } };
struct FResX { const float* xp; const float* xs; float* h;
    __device__ __forceinline__ void operator()(int row, int col, const f32x4& v) const {
        const float* x = (row < MP) ? (xp + (size_t)row * 1024 + col) : (xs + (size_t)(row - MP) * 1024 + col);
        *(f32x4*)(h + (size_t)row * 1024 + col) = *(const f32x4*)x + v; } };
struct FAcc { float* h; int row_off;
    __device__ __forceinline__ void operator()(int row, int col, const f32x4& v) const {
        float* d = h + (size_t)(row + row_off) * 1024 + col; *(f32x4*)d = *(const f32x4*)d + v; } };

struct FGateA8 { const bf16_t* Z; bf16_t* t1;
    struct L { u32x4 g; };
    __device__ __forceinline__ L load(int row, int col) const { L l; l.g = *(const u32x4*)(Z + (size_t)row * NZ + ZGA + col); return l; }
    __device__ __forceinline__ void apply(int row, int col, const f32x4& v0, const f32x4& v1, const L& l) const {
        const u32x4 g = l.g;
        u32x4 w; w.x = pk2(sigm(bflo(g.x)) * v0[0], sigm(bfhi(g.x)) * v0[1]); w.y = pk2(sigm(bflo(g.y)) * v0[2], sigm(bfhi(g.y)) * v0[3]);
        w.z = pk2(sigm(bflo(g.z)) * v1[0], sigm(bfhi(g.z)) * v1[1]); w.w = pk2(sigm(bflo(g.w)) * v1[2], sigm(bfhi(g.w)) * v1[3]);
        *(u32x4*)(t1 + (size_t)row * 1024 + col) = w; } };
struct FGateB8 { const bf16_t* Z; const bf16_t* t1; bf16_t* mix;
    struct L { u32x4 g, t; };
    __device__ __forceinline__ L load(int row, int col) const { L l; l.g = *(const u32x4*)(Z + (size_t)row * NZ + ZGB + col); l.t = *(const u32x4*)(t1 + (size_t)row * 1024 + col); return l; }
    __device__ __forceinline__ void apply(int row, int col, const f32x4& v0, const f32x4& v1, const L& l) const {
        const u32x4 g = l.g, tw = l.t;
        u32x4 w; w.x = pk2(bflo(tw.x) + sigm(bflo(g.x)) * v0[0], bfhi(tw.x) + sigm(bfhi(g.x)) * v0[1]); w.y = pk2(bflo(tw.y) + sigm(bflo(g.y)) * v0[2], bfhi(tw.y) + sigm(bfhi(g.y)) * v0[3]);
        w.z = pk2(bflo(tw.z) + sigm(bflo(g.z)) * v1[0], bfhi(tw.z) + sigm(bfhi(g.z)) * v1[1]); w.w = pk2(bflo(tw.w) + sigm(bflo(g.w)) * v1[2], bfhi(tw.w) + sigm(bfhi(g.w)) * v1[3]);
        *(u32x4*)(mix + (size_t)row * 1024 + col) = w; } };
struct FResX8 { const float* xp; float* h;
    struct L { f32x4 a, b; };
    __device__ __forceinline__ L load(int row, int col) const { const float* x = xp + (size_t)row * 1024 + col; L l; l.a = *(const f32x4*)x; l.b = *(const f32x4*)(x + 4); return l; }
    __device__ __forceinline__ void apply(int row, int col, const f32x4& v0, const f32x4& v1, const L& l) const {
        float* d = h + (size_t)row * 1024 + col; *(f32x4*)d = l.a + v0; *(f32x4*)(d + 4) = l.b + v1; } };
struct FAcc8 { float* h;
    struct L { f32x4 a, b; };
    __device__ __forceinline__ L load(int row, int col) const { const float* x = h + (size_t)row * 1024 + col; L l; l.a = *(const f32x4*)x; l.b = *(const f32x4*)(x + 4); return l; }
    __device__ __forceinline__ void apply(int row, int col, const f32x4& v0, const f32x4& v1, const L& l) const {
        float* d = h + (size_t)row * 1024 + col; *(f32x4*)d = l.a + v0; *(f32x4*)(d + 4) = l.b + v1; } };
struct FAccAtomic { float* h;
    __device__ __forceinline__ void operator()(int row, int col, const f32x4& v) const {
        float* d = h + (size_t)row * 1024 + col;
#pragma unroll
        for (int e = 0; e < 4; ++e) (void)__hip_atomic_fetch_add(d + e, v[e], __ATOMIC_RELAXED, __HIP_MEMORY_SCOPE_AGENT); } };

__device__ __forceinline__ void transpose_item(const float* __restrict__ W, int ldw, int col0, int K, int ncols, bf16_t* WT, int row_off, LAS float* scr, int item, int lane) {
    const int nblk = ncols / 32, kb = item / nblk, nb = item % nblk, k0 = 64 * kb, n0 = 32 * nb;
#pragma unroll
    for (int i = 0; i < 32; ++i) { const int kk = 2 * i + (lane >> 5); scr[kk * 33 + (lane & 31)] = W[(size_t)(k0 + kk) * ldw + col0 + n0 + (lane & 31)]; }
    asm volatile("s_waitcnt lgkmcnt(0)" ::: "memory");
    const int c = lane & 7;
#pragma unroll
    for (int j = 0; j < 4; ++j) { const int n = (lane >> 3) + 8 * j; const LAS float* s = scr + (8 * c) * 33 + n;
        u32x4 o; o.x = pk2(s[0 * 33], s[1 * 33]); o.y = pk2(s[2 * 33], s[3 * 33]); o.z = pk2(s[4 * 33], s[5 * 33]); o.w = pk2(s[6 * 33], s[7 * 33]);
        *(u32x4*)(WT + (size_t)(row_off + n0 + n) * K + k0 + 8 * c) = o; }
    asm volatile("s_waitcnt lgkmcnt(0)" ::: "memory");
}

template <bool DAB>
__device__ __forceinline__ void norm_row_bf16(const float* xrow, const float* g, bf16_t* orow, int lane, const LAS float* sW, float* gb_out, const float* alog, const float* dtb) {
    f32x4 v[4]; float ss = 0.f;
#pragma unroll
    for (int j = 0; j < 4; ++j) { v[j] = ((const f32x4*)xrow)[lane + 64 * j]; ss += (v[j][0] * v[j][0] + v[j][1] * v[j][1]) + (v[j][2] * v[j][2] + v[j][3] * v[j][3]); }
    const float rs = __builtin_amdgcn_rsqf(wave_sum(ss) * (1.f / 1024.f) + EPS);
#pragma unroll
    for (int j = 0; j < 4; ++j) { const f32x4 gg = ((const f32x4*)g)[lane + 64 * j]; v[j] = v[j] * rs * gg;
        u32x2 w; w.x = pk2(v[j][0], v[j][1]); w.y = pk2(v[j][2], v[j][3]); ((u32x2*)orow)[lane + 64 * j] = w; }
    if constexpr (DAB) {
        float acc[8];
#pragma unroll
        for (int i = 0; i < 8; ++i) acc[i] = 0.f;
#pragma unroll
        for (int j = 0; j < 4; ++j)
#pragma unroll
            for (int e = 0; e < 4; ++e) { const int k = 4 * lane + 256 * j + e; const f32x4 w0 = *(const LAS f32x4*)(sW + k * 8), w1 = *(const LAS f32x4*)(sW + k * 8 + 4); const float x = v[j][e];
                acc[0] += x * w0[0]; acc[1] += x * w0[1]; acc[2] += x * w0[2]; acc[3] += x * w0[3]; acc[4] += x * w1[0]; acc[5] += x * w1[1]; acc[6] += x * w1[2]; acc[7] += x * w1[3]; }
#pragma unroll
        for (int i = 0; i < 8; ++i) acc[i] = wave_sum(acc[i]);
        if (lane == 0) {
            f32x4 o0, o1;
#pragma unroll
            for (int i = 0; i < 4; ++i) { const float x = acc[i] + dtb[i]; const float sp = (x > 20.f) ? x : log1pf(expf(x)); o0[i] = -expf(alog[i]) * sp; o1[i] = 1.f / (1.f + expf(-acc[4 + i])); }
            *(f32x4*)gb_out = o0; *(f32x4*)(gb_out + 4) = o1;
        }
    }
}

__device__ __forceinline__ void p0_prologue(const Params& p, LAS unsigned char* lds, int tid, int lane, int wave, int G) {
    unsigned char* ws = p.ws;
    LAS float* scr = (LAS float*)(lds + wave * 16384);
    const int gw = blockIdx.x * 8 + wave, NGW = G * 8;
    constexpr int I1 = 16 * 88, I2 = 16 * 64, I3 = 8 * 32, I5 = 16 * 32, I6 = 16 * 16, I9 = 16 * 176, I10 = 44 * 32;
    constexpr int NITEMS = I1 + I2 + I3 + I3;
    for (int it = gw; it < NITEMS; it += NGW) {
        int r = it;
        if (r < I1) { transpose_item(p.in[11], 4872, 0, 1024, 2816, (bf16_t*)(ws + WS_WIN), 0, scr, r, lane); continue; } r -= I1;
        if (r < I2) { transpose_item(p.in[11], 4872, 2824, 1024, 2048, (bf16_t*)(ws + WS_WIN), 2816, scr, r, lane); continue; } r -= I2;
        if (r < I3) { transpose_item(p.in[17], 1024, 0, 512, 1024, (bf16_t*)(ws + WS_WA), 0, scr, r, lane); continue; } r -= I3;
        transpose_item(p.in[18], 1024, 0, 512, 1024, (bf16_t*)(ws + WS_WB), 0, scr, r, lane);
    }
    (void)I5; (void)I6;
    {
        float* tab = (float*)(ws + WS_ROPE);
        for (int idx = blockIdx.x * NTHR + tid; idx < 2052 * 8; idx += G * NTHR) {
            const int pi = idx >> 3, i = idx & 7; const int pos = pi < 2048 ? pi : 16384 + (pi - 2048);
            double t = (double)pos * p.inv[i] * 0.15915494309189535; t -= __builtin_floor(t);
            const float r = (float)t;
            tab[idx * 2] = __builtin_amdgcn_cosf(r); tab[idx * 2 + 1] = __builtin_amdgcn_sinf(r);
        }
    }
    __syncthreads();
    LAS float* sW = (LAS float*)lds;
    for (int e = tid; e < 8192; e += NTHR) sW[e] = p.in[11][(size_t)(e >> 3) * 4872 + 2816 + (e & 7)];
    __syncthreads();
    for (int m = gw; m < MT; m += 2 * NGW) {
        const int mb = (m + NGW < MT) ? (m + NGW) : m;
        const float* xa = (m < MP) ? p.in[0] + (size_t)m * 1024 : p.in[1] + (size_t)(m - MP) * 1024;
        const float* xb = (mb < MP) ? p.in[0] + (size_t)mb * 1024 : p.in[1] + (size_t)(mb - MP) * 1024;
        f32x4 va[4], vb[4]; float sa = 0.f, sb = 0.f;
#pragma unroll
        for (int j = 0; j < 4; ++j) { va[j] = ((const f32x4*)xa)[lane + 64 * j]; vb[j] = ((const f32x4*)xb)[lane + 64 * j]; }
#pragma unroll
        for (int j = 0; j < 4; ++j) { sa += (va[j][0] * va[j][0] + va[j][1] * va[j][1]) + (va[j][2] * va[j][2] + va[j][3] * va[j][3]); sb += (vb[j][0] * vb[j][0] + vb[j][1] * vb[j][1]) + (vb[j][2] * vb[j][2] + vb[j][3] * vb[j][3]); }
#pragma unroll
        for (int o = 1; o < 64; o <<= 1) { sa += __shfl_xor(sa, o); sb += __shfl_xor(sb, o); }
        const float ra = __builtin_amdgcn_rsqf(sa * (1.f / 1024.f) + EPS), rb = __builtin_amdgcn_rsqf(sb * (1.f / 1024.f) + EPS);
        float acc[16];
#pragma unroll
        for (int i = 0; i < 16; ++i) acc[i] = 0.f;
        bf16_t* oa = (bf16_t*)(ws + WS_RA) + (size_t)m * 1024; bf16_t* ob = (bf16_t*)(ws + WS_RA) + (size_t)mb * 1024;
#pragma unroll
        for (int j = 0; j < 4; ++j) { const f32x4 gg = ((const f32x4*)p.in[10])[lane + 64 * j]; va[j] = va[j] * ra * gg; vb[j] = vb[j] * rb * gg;
            u32x2 w; w.x = pk2(va[j][0], va[j][1]); w.y = pk2(va[j][2], va[j][3]); ((u32x2*)oa)[lane + 64 * j] = w;
            u32x2 w2; w2.x = pk2(vb[j][0], vb[j][1]); w2.y = pk2(vb[j][2], vb[j][3]); ((u32x2*)ob)[lane + 64 * j] = w2;
#pragma unroll
            for (int e = 0; e < 4; ++e) { const int k = 4 * lane + 256 * j + e; const f32x4 w0 = *(const LAS f32x4*)(sW + k * 8), w1 = *(const LAS f32x4*)(sW + k * 8 + 4); const float xA = va[j][e], xB = vb[j][e];
                acc[0] += xA * w0[0]; acc[1] += xA * w0[1]; acc[2] += xA * w0[2]; acc[3] += xA * w0[3]; acc[4] += xA * w1[0]; acc[5] += xA * w1[1]; acc[6] += xA * w1[2]; acc[7] += xA * w1[3];
                acc[8] += xB * w0[0]; acc[9] += xB * w0[1]; acc[10] += xB * w0[2]; acc[11] += xB * w0[3]; acc[12] += xB * w1[0]; acc[13] += xB * w1[1]; acc[14] += xB * w1[2]; acc[15] += xB * w1[3]; } }
#pragma unroll
        for (int o = 1; o < 64; o <<= 1) {
#pragma unroll
            for (int i = 0; i < 16; ++i) acc[i] += __shfl_xor(acc[i], o); }
        if (lane < 2) { const int r = lane ? mb : m; const float* a8 = acc;
            f32x4 o0, o1;
#pragma unroll
            for (int i = 0; i < 4; ++i) { const float da = lane ? a8[8 + i] : a8[i], db = lane ? a8[12 + i] : a8[4 + i];
                const float x = da + p.in[14][i]; const float sp = (x > 20.f) ? x : log1pf(expf(x)); o0[i] = -expf(p.in[13][i]) * sp; o1[i] = 1.f / (1.f + expf(-db)); }
            float* gbo = (float*)(ws + WS_GB) + (size_t)r * 8; *(f32x4*)gbo = o0; *(f32x4*)(gbo + 4) = o1; }
    }
    for (int m = gw; m < 2048; m += NGW)
        norm_row_bf16<false>(p.in[2] + (size_t)m * 1024, p.in[21], (bf16_t*)(ws + WS_MEMN) + (size_t)m * 1024, lane, sW, nullptr, nullptr, nullptr);
}

#define MFMA16(a, b, c) __builtin_amdgcn_mfma_f32_16x16x32_bf16(a, b, c, 0, 0, 0)
__device__ __forceinline__ bf16x8 pack_p(const f32x4& a, const f32x4& b) {
    u32x4 w; w.x = pk2(a[0], a[1]); w.y = pk2(a[2], a[3]); w.z = pk2(b[0], b[1]); w.w = pk2(b[2], b[3]); return __builtin_bit_cast(bf16x8, w);
}

__device__ __forceinline__ void swa_prompt_item(const Params& p, LAS unsigned char* lds, int item, int tid, int lane, int wave) {
    const int kvh = item & 1, blk = (item >> 1) & 15, b = item >> 5;
    const bf16_t* Z = (const bf16_t*)(p.ws + WS_Z);
    const float* tab = (const float*)(p.ws + WS_ROPE);
    LAS bf16_t* sK = (LAS bf16_t*)lds;
    LAS bf16_t* sVt = (LAS bf16_t*)(lds + 36864);
    {
        const int key = tid >> 1, half = tid & 1;
        const int pos = blk * 128 - 128 + key;
        u32x4 k4[4], v4[4];
        if (pos >= 0) { const bf16_t* zr = Z + (size_t)(b * 2048 + pos) * NZ;
#pragma unroll
            for (int i = 0; i < 4; ++i) { k4[i] = *(const u32x4*)(zr + ZK + kvh * 64 + 32 * half + 8 * i); v4[i] = *(const u32x4*)(zr + ZV + kvh * 64 + 32 * half + 8 * i); }
            if (half == 0) {
                const f32x4* cs = (const f32x4*)(tab + (size_t)pos * 16);
                u32x4 r1, r2;
#pragma unroll
                for (int w = 0; w < 4; ++w) { const f32x4 c4 = cs[w];
                    const float a0 = bflo(k4[0][w]), a1 = bfhi(k4[0][w]), b0 = bflo(k4[1][w]), b1 = bfhi(k4[1][w]);
                    r1[w] = pk2(a0 * c4[0] - b0 * c4[1], a1 * c4[2] - b1 * c4[3]);
                    r2[w] = pk2(b0 * c4[0] + a0 * c4[1], b1 * c4[2] + a1 * c4[3]); }
                k4[0] = r1; k4[1] = r2;
            }
        } else {
#pragma unroll
            for (int i = 0; i < 4; ++i) { k4[i] = (u32x4){0u, 0u, 0u, 0u}; v4[i] = (u32x4){0u, 0u, 0u, 0u}; }
        }
#pragma unroll
        for (int i = 0; i < 4; ++i) *(LAS u32x4*)(sK + key * 72 + 32 * half + 8 * i) = k4[i];
#pragma unroll
        for (int i = 0; i < 4; ++i)
#pragma unroll
            for (int w = 0; w < 4; ++w) { sVt[(32 * half + 8 * i + 2 * w) * 264 + key] = (bf16_t)(v4[i][w] & 0xffffu); sVt[(32 * half + 8 * i + 2 * w + 1) * 264 + key] = (bf16_t)(v4[i][w] >> 16); }
        if (blk == 15 && key >= 128) {
            float* ok = p.out + O_PWK + ((size_t)(b * 128 + key - 128) * 2 + kvh) * 64 + 32 * half;
            float* ov = p.out + O_PWV + ((size_t)(b * 128 + key - 128) * 2 + kvh) * 64 + 32 * half;
#pragma unroll
            for (int i = 0; i < 4; ++i) {
                *(f32x4*)(ok + 8 * i) = (f32x4){bflo(k4[i][0]), bfhi(k4[i][0]), bflo(k4[i][1]), bfhi(k4[i][1])};
                *(f32x4*)(ok + 8 * i + 4) = (f32x4){bflo(k4[i][2]), bfhi(k4[i][2]), bflo(k4[i][3]), bfhi(k4[i][3])};
                *(f32x4*)(ov + 8 * i) = (f32x4){bflo(v4[i][0]), bfhi(v4[i][0]), bflo(v4[i][1]), bfhi(v4[i][1])};
                *(f32x4*)(ov + 8 * i + 4) = (f32x4){bflo(v4[i][2]), bfhi(v4[i][2]), bflo(v4[i][3]), bfhi(v4[i][3])};
            }
        }
    }
    LBAR();
    {
        const int g = wave >> 1, hq = kvh * 4 + g;
        const int l15 = lane & 15, q4 = lane >> 4;
        const float sink = p.in[16][hq];
        bf16_t* ya = (bf16_t*)(p.ws + WS_YA);
#pragma unroll 1
        for (int qp = 0; qp < 2; ++qp) {
        const int qbase = 64 * (wave & 1) + 32 * qp;
        bf16x8 qf[2][2];
#pragma unroll
        for (int qb = 0; qb < 2; ++qb) {
            const int qpos = blk * 128 + qbase + 16 * qb + l15;
            const bf16_t* zr = Z + (size_t)(b * 2048 + qpos) * NZ + hq * 64;
            qf[qb][0] = *(const bf16x8*)(zr + 8 * q4); qf[qb][1] = *(const bf16x8*)(zr + 32 + 8 * q4);
            const u32x4 own = __builtin_bit_cast(u32x4, qf[qb][0]); u32x4 oth;
#pragma unroll
            for (int w = 0; w < 4; ++w) oth[w] = (unsigned)__shfl_xor((int)own[w], 16);
            if (q4 < 2) {
                const f32x4* cs = (const f32x4*)(tab + (size_t)qpos * 16);
                const float sg = (q4 == 0) ? -1.f : 1.f; u32x4 r;
#pragma unroll
                for (int w = 0; w < 4; ++w) { const f32x4 c4 = cs[w];
                    r[w] = pk2(bflo(own[w]) * c4[0] + sg * bflo(oth[w]) * c4[1], bfhi(own[w]) * c4[2] + sg * bfhi(oth[w]) * c4[3]); }
                qf[qb][0] = __builtin_bit_cast(bf16x8, r);
            }
        }
        f32x4 o[4][2]; float mrow[2], lrow[2];
#pragma unroll
        for (int qb = 0; qb < 2; ++qb) { mrow[qb] = sink; lrow[qb] = (q4 == 0) ? 1.f : 0.f;
#pragma unroll
            for (int db = 0; db < 4; ++db) o[db][qb] = (f32x4){0.f, 0.f, 0.f, 0.f}; }
        int kt_lo = (wave & 1) ? 1 : 0; const int kt_hi = kt_lo + 3; if (blk == 0) kt_lo = 2;
        for (int kt = kt_lo; kt < kt_hi; ++kt) {
            f32x4 s[4][2];
#pragma unroll
            for (int kb = 0; kb < 4; ++kb) {
                const LAS bf16_t* kr = sK + (64 * kt + 16 * kb + l15) * 72 + 8 * q4;
                const bf16x8 kf0 = *(const LAS bf16x8*)kr, kf1 = *(const LAS bf16x8*)(kr + 32);
#pragma unroll
                for (int qb = 0; qb < 2; ++qb) { f32x4 z = (f32x4){0.f, 0.f, 0.f, 0.f}; z = MFMA16(kf0, qf[qb][0], z); s[kb][qb] = MFMA16(kf1, qf[qb][1], z); }
            }
#pragma unroll
            for (int qb = 0; qb < 2; ++qb) {
                const int i = qbase + 16 * qb + l15;
                float mx = -1e30f;
#pragma unroll
                for (int kb = 0; kb < 4; ++kb)
#pragma unroll
                    for (int r = 0; r < 4; ++r) { const int j = 64 * kt + 16 * kb + 4 * q4 + r; const bool ok = (unsigned)(j - i - 1) < 128u;
                        const float v = ok ? s[kb][qb][r] * 0.125f : -1e30f; s[kb][qb][r] = v; mx = fmaxf(mx, v); }
                mx = fmaxf(mx, __shfl_xor(mx, 16)); mx = fmaxf(mx, __shfl_xor(mx, 32));
                const float mn = fmaxf(mrow[qb], mx), alpha = __expf(mrow[qb] - mn); mrow[qb] = mn;
                float ls = lrow[qb] * alpha;
#pragma unroll
                for (int db = 0; db < 4; ++db) o[db][qb] = o[db][qb] * alpha;
#pragma unroll
                for (int kb = 0; kb < 4; ++kb)
#pragma unroll
                    for (int r = 0; r < 4; ++r) { const float pv = __expf(s[kb][qb][r] - mn); ls += pv; s[kb][qb][r] = pv; }
                lrow[qb] = ls;
            }
#pragma unroll
            for (int s2 = 0; s2 < 2; ++s2) {
                bf16x8 pb[2];
#pragma unroll
                for (int qb = 0; qb < 2; ++qb) pb[qb] = pack_p(s[2 * s2][qb], s[2 * s2 + 1][qb]);
#pragma unroll
                for (int db = 0; db < 4; ++db) {
                    const LAS bf16_t* vr = sVt + (16 * db + l15) * 264 + 64 * kt + 32 * s2 + 4 * q4;
                    const s16x4 lo = *(const LAS s16x4*)vr, hi = *(const LAS s16x4*)(vr + 16);
                    const bf16x8 vf = __builtin_shufflevector(lo, hi, 0, 1, 2, 3, 4, 5, 6, 7);
#pragma unroll
                    for (int qb = 0; qb < 2; ++qb) o[db][qb] = MFMA16(vf, pb[qb], o[db][qb]);
                }
            }
        }
#pragma unroll
        for (int qb = 0; qb < 2; ++qb) {
            float lt = lrow[qb]; lt += __shfl_xor(lt, 16); lt += __shfl_xor(lt, 32); const float inv = __builtin_amdgcn_rcpf(lt);
            const int row = b * 2048 + blk * 128 + qbase + 16 * qb + l15;
#pragma unroll
            for (int db = 0; db < 4; ++db) { u32x2 w; w.x = pk2(o[db][qb][0] * inv, o[db][qb][1] * inv); w.y = pk2(o[db][qb][2] * inv, o[db][qb][3] * inv);
                *(u32x2*)(ya + (size_t)row * 512 + hq * 64 + 16 * db + 4 * q4) = w; }
        }
        }
    }
    LBAR();
}

__device__ __forceinline__ void swa_sample_item(const Params& p, LAS unsigned char* lds, int item, int tid) {
    const int kv = item & 1, b = item >> 1;
    const bf16_t* Z = (const bf16_t*)(p.ws + WS_Z);
    const float* tab = (const float*)(p.ws + WS_ROPE);
    LAS float* sK = (LAS float*)lds;
    LAS float* sV = sK + 132 * 65;
    LAS float* sQ = sV + 132 * 64;
    LAS float* sP = sQ + 16 * 64;
    const float* cwk = p.in[3]; const float* cwv = p.in[4];
#pragma unroll 4
    for (int n = 0; n < 16; ++n) { const int e = tid + 512 * n, j = e >> 6, d = e & 63; const size_t a = ((size_t)(b * 128 + j) * 2 + kv) * 64 + d;
        sK[j * 65 + d] = cwk[a]; sV[j * 64 + d] = cwv[a]; }
    if (tid < 256) { const int t = tid >> 6, d = tid & 63; const bf16_t* zr = Z + (size_t)(MP + 4 * b + t) * NZ;
        sK[(128 + t) * 65 + d] = bf2f(zr[ZK + kv * 64 + d]); sV[(128 + t) * 64 + d] = bf2f(zr[ZV + kv * 64 + d]); }
#pragma unroll
    for (int n = 0; n < 2; ++n) { const int e = tid + 512 * n, qi = e >> 6, d = e & 63, t = qi >> 2, g = qi & 3;
        sQ[qi * 64 + d] = bf2f(Z[(size_t)(MP + 4 * b + t) * NZ + (kv * 4 + g) * 64 + d]); }
    LBAR();
    if (tid < 32) { const int t = tid >> 3, i = tid & 7; const float c = tab[((2048 + t) * 8 + i) * 2], s = tab[((2048 + t) * 8 + i) * 2 + 1];
        LAS float* x = sK + (128 + t) * 65; const float x1 = x[i], x2 = x[i + 8]; x[i] = x1 * c - x2 * s; x[i + 8] = x2 * c + x1 * s; }
    else if (tid >= 64 && tid < 192) { const int idx = tid - 64, qi = idx >> 3, i = idx & 7, t = qi >> 2; const float c = tab[((2048 + t) * 8 + i) * 2], s = tab[((2048 + t) * 8 + i) * 2 + 1];
        LAS float* x = sQ + qi * 64; const float x1 = x[i], x2 = x[i + 8]; x[i] = x1 * c - x2 * s; x[i + 8] = x2 * c + x1 * s; }
    LBAR();
#pragma unroll 4
    for (int n = 0; n < 16; ++n) { const int e = tid + 512 * n, jj = e >> 6, d = e & 63; const size_t a = ((size_t)(b * 128 + jj) * 2 + kv) * 64 + d;
        p.out[O_SWK + a] = sK[(jj + 4) * 65 + d]; p.out[O_SWV + a] = sV[(jj + 4) * 64 + d]; }
    const int qi = tid >> 5, jl = tid & 31, t = qi >> 2, g = qi & 3;
    const float sink = p.in[16][kv * 4 + g];
    float sc[5]; float mx = sink;
#pragma unroll
    for (int n = 0; n < 5; ++n) { const int j = jl + 32 * n; float v = -1e30f;
        if (j < 132 && j >= t + 1 && j <= t + 128) { float dot = 0.f;
#pragma unroll 16
            for (int d = 0; d < 64; ++d) dot += sQ[qi * 64 + d] * sK[j * 65 + d];
            v = dot * 0.125f; }
        sc[n] = v; mx = fmaxf(mx, v); }
#pragma unroll
    for (int o = 1; o < 32; o <<= 1) mx = fmaxf(mx, __shfl_xor(mx, o));
    float sum = 0.f;
#pragma unroll
    for (int n = 0; n < 5; ++n) { const float pv = __expf(sc[n] - mx); sum += pv; sc[n] = pv; }
#pragma unroll
    for (int o = 1; o < 32; o <<= 1) sum += __shfl_xor(sum, o);
    sum += __expf(sink - mx);
    const float inv = 1.f / sum;
#pragma unroll
    for (int n = 0; n < 5; ++n) { const int j = jl + 32 * n; if (j < 132) sP[qi * 132 + j] = sc[n] * inv; }
    LBAR();
    {
        const int d0 = jl * 2; float a0 = 0.f, a1 = 0.f;
        for (int j = 0; j < 132; ++j) { const float pj = sP[qi * 132 + j]; a0 += pj * sV[j * 64 + d0]; a1 += pj * sV[j * 64 + d0 + 1]; }
        bf16_t* ya = (bf16_t*)(p.ws + WS_YA);
        *(unsigned*)(ya + (size_t)(MP + 4 * b + t) * 512 + (kv * 4 + g) * 64 + d0) = pk2(a0, a1);
    }
    LBAR();
}

__device__ __forceinline__ float dn_ld(const bf16_t* Z, const float* cbuf, int row0, int tok, int cc) {
    return tok >= 0 ? bf2f(Z[(size_t)(row0 + tok) * NZ + ZDQ + cc]) : (cbuf ? cbuf[(3 + tok) * 1536 + cc] : 0.f);
}
template <int CG, int RS, int TB>
__device__ __forceinline__ void dn_scan_item(const Params& p, LAS unsigned char* lds, int row0, int L, int h, int cg, const float* S0, const float* cbuf, float* Sout, int tid) {
    static_assert(CG * RS == NTHR, "thread map");
    constexpr int R = 128 / RS;
    LAS float* sq = (LAS float*)lds;
    LAS float* sk = sq + TB * 128;
    LAS float* sv = sk + TB * 128;
    LAS float* sa = sv + TB * CG;
    LAS float* sb = sa + TB;
    const bf16_t* Z = (const bf16_t*)(p.ws + WS_Z);
    const float* cw = p.in[12];
    const float* gbuf = (const float*)(p.ws + WS_GB);
    bf16_t* oraw = (bf16_t*)(p.ws + WS_RA);
    const int c = tid / RS, rs = tid % RS;
    float S[R];
#pragma unroll
    for (int r = 0; r < R; ++r) S[r] = S0 ? S0[(size_t)(rs * R + r) * 128 + cg * CG + c] : 0.f;
    for (int t0 = 0; t0 < L; t0 += TB) {
        {
            const int ch = tid & 255, half = tid >> 8;
            const int cc = (ch < 128) ? (h * 128 + ch) : (512 + h * 128 + (ch - 128));
            const float w0 = cw[cc], w1 = cw[1536 + cc], w2 = cw[2 * 1536 + cc], w3 = cw[3 * 1536 + cc];
            constexpr int TH = TB / 2;
            const int tb = t0 + half * TH;
            float x0 = dn_ld(Z, cbuf, row0, tb - 3, cc), x1 = dn_ld(Z, cbuf, row0, tb - 2, cc), x2 = dn_ld(Z, cbuf, row0, tb - 1, cc);
            LAS float* dst = ((ch < 128) ? sq : sk) + (ch & 127);
#pragma unroll 4
            for (int i = 0; i < TH; ++i) { const float x3 = dn_ld(Z, cbuf, row0, tb + i, cc); dst[(half * TH + i) * 128] = silu(w0 * x0 + w1 * x1 + w2 * x2 + w3 * x3); x0 = x1; x1 = x2; x2 = x3; }
        }
        for (int e = tid; e < TB * CG; e += NTHR) { const int tt = e / CG, c2 = e % CG, cc = 1024 + h * 128 + cg * CG + c2, tok = t0 + tt;
            const float y = cw[cc] * dn_ld(Z, cbuf, row0, tok - 3, cc) + cw[1536 + cc] * dn_ld(Z, cbuf, row0, tok - 2, cc) + cw[2 * 1536 + cc] * dn_ld(Z, cbuf, row0, tok - 1, cc) + cw[3 * 1536 + cc] * dn_ld(Z, cbuf, row0, tok, cc);
            sv[tt * CG + c2] = silu(y); }
        if (tid < TB) { const size_t row = (size_t)(row0 + t0 + tid); sa[tid] = __expf(gbuf[row * 8 + h]); sb[tid] = gbuf[row * 8 + 4 + h]; }
        LBAR();
        for (int ri = tid >> 2; ri < 2 * TB; ri += NTHR / 4) {
            LAS float* rp = (ri < TB) ? (sq + ri * 128) : (sk + (ri - TB) * 128);
            const int sh = (tid & 3) + 4 * ri;
            float ss = 0.f;
#pragma unroll
            for (int i = 0; i < 32; ++i) { const float x = rp[(4 * i + sh) & 127]; ss += x * x; }
            ss += __shfl_xor(ss, 1); ss += __shfl_xor(ss, 2);
            const float scl = __builtin_amdgcn_rsqf(ss + EPS) * ((ri < TB) ? 0.08838834764831845f : 1.f);
#pragma unroll
            for (int i = 0; i < 32; ++i) rp[(4 * i + sh) & 127] *= scl;
        }
        LBAR();
        for (int tt = 0; tt < TB; ++tt) {
            const float a = sa[tt], bt = sb[tt], vv = sv[tt * CG + c];
            float kk[R]; float part = 0.f;
#pragma unroll
            for (int r = 0; r < R; ++r) { kk[r] = sk[tt * 128 + rs * R + r]; part += kk[r] * S[r]; }
#pragma unroll
            for (int o = 1; o < RS; o <<= 1) part += __shfl_xor(part, o);
            const float vn = bt * (vv - a * part);
            float op = 0.f;
#pragma unroll
            for (int r = 0; r < R; ++r) { S[r] = a * S[r] + kk[r] * vn; op += sq[tt * 128 + rs * R + r] * S[r]; }
#pragma unroll
            for (int o = 1; o < RS; o <<= 1) op += __shfl_xor(op, o);
            if (rs == 0) oraw[(size_t)(row0 + t0 + tt) * 512 + h * 128 + cg * CG + c] = (bf16_t)f2bf(op);
        }
        LBAR();
    }
#pragma unroll
    for (int r = 0; r < R; ++r) Sout[(size_t)(rs * R + r) * 128 + cg * CG + c] = S[r];
}


__device__ __forceinline__ bf16x8 frag64(const LAS bf16_t* ptr) {
    const s16x4 lo = *(const LAS s16x4*)ptr, hi = *(const LAS s16x4*)(ptr + 16);
    return __builtin_shufflevector(lo, hi, 0, 1, 2, 3, 4, 5, 6, 7);
}
__device__ __forceinline__ void dn_chunk_prep(const Params& p, LAS unsigned char* lds, int u, int tid, int lane, int wave) {
    const int n = u & 31, h = (u >> 5) & 3, b = u >> 7;
    const int row0 = b * 2048 + n * 64;
    LAS float* sq = (LAS float*)lds;
    LAS float* sk = sq + 64 * 128;
    LAS bf16_t* Kb = (LAS bf16_t*)(lds + 65536);
    LAS bf16_t* Qb = Kb + 64 * 136;
    LAS float* sgam = (LAS float*)(lds + 65536 + 2 * 17408);
    LAS float* sbeta = sgam + 64;
    LAS float* seg = sbeta + 64;
    LAS float* sek = seg + 64;
    LAS float* srq = sek + 64;
    LAS float* srk = srq + 64;
    LAS float* sA = sq;
    const bf16_t* Z = (const bf16_t*)(p.ws + WS_Z);
    const float* cw = p.in[12];
    const float* gbuf = (const float*)(p.ws + WS_GB);
    bf16_t* img = (bf16_t*)p.out + (size_t)u * 32768;
    bf16_t* mimg = (bf16_t*)(p.ws + WS_YB) + (size_t)u * 4096;
    const int type = wave >> 1, d = (wave & 1) * 64 + lane;
    float x[64];
    if (type < 3) {
        const int cc = type * 512 + h * 128 + d;
        const float w0 = cw[cc], w1 = cw[1536 + cc], w2 = cw[2 * 1536 + cc], w3 = cw[3 * 1536 + cc];
        const int tk = n * 64;
        const bf16_t* zrow = Z + ((size_t)(b * 2048 + tk) - 3) * NZ + ZDQ + type * 512 + h * 128 + (wave & 1) * 64;
        float x0 = 0.f, x1 = 0.f, x2 = 0.f;
        if (n > 0) { x0 = bf2f(zrow[lane]); x1 = bf2f(zrow[NZ + lane]); x2 = bf2f(zrow[2 * NZ + lane]); }
        zrow += 3 * NZ;
#pragma unroll
        for (int t8 = 0; t8 < 4; ++t8) {
#pragma unroll
            for (int e = 0; e < 16; ++e) { const float x3 = bf2f(zrow[lane]); zrow += NZ; x[16 * t8 + e] = silu(w0 * x0 + w1 * x1 + w2 * x2 + w3 * x3); x0 = x1; x1 = x2; x2 = x3; }
            asm volatile("" ::: "memory"); }
        if (type < 2) { LAS float* dst = (type ? sk : sq) + d;
#pragma unroll
            for (int t = 0; t < 64; ++t) dst[t * 128] = x[t]; }
    } else {
#pragma unroll
        for (int t = 0; t < 64; ++t) x[t] = 0.f;
        if (wave == 7) {
            float g = gbuf[(size_t)(row0 + lane) * 8 + h]; const float be = gbuf[(size_t)(row0 + lane) * 8 + 4 + h];
#pragma unroll
            for (int o = 1; o < 64; o <<= 1) { const float v = __shfl_up(g, o); if (lane >= o) g += v; }
            const float glast = __shfl(g, 63);
            sgam[lane] = g; sbeta[lane] = be; seg[lane] = __expf(g); sek[lane] = __expf(glast - g);
            if (lane == 0) ((float*)(p.ws + WS_GLAST))[u] = __expf(glast);
        }
    }
    LBAR();
    {
        const int ri = tid >> 2; LAS float* rp = (ri < 64) ? (sq + ri * 128) : (sk + (ri - 64) * 128);
        const int sh = (tid & 3) + 4 * ri; float ss = 0.f;
#pragma unroll
        for (int i = 0; i < 32; ++i) { const float v = rp[(4 * i + sh) & 127]; ss += v * v; }
        ss += __shfl_xor(ss, 1); ss += __shfl_xor(ss, 2);
        if ((tid & 3) == 0) { if (ri < 64) srq[ri] = __builtin_amdgcn_rsqf(ss + EPS) * 0.08838834764831845f; else srk[ri - 64] = __builtin_amdgcn_rsqf(ss + EPS); }
    }
    LBAR();
    {
        int vz; asm volatile("v_mov_b32 %0, 0" : "=v"(vz));
        if (type == 0) {
#pragma unroll
            for (int t8 = 0; t8 < 8; ++t8) {
#pragma unroll
                for (int e = 0; e < 8; ++e) { const int t = 8 * t8 + e; const float v = x[t] * srq[t + vz]; Qb[t * 136 + d] = (bf16_t)f2bf(v); img[8192 + t * 128 + d] = (bf16_t)f2bf(v * seg[t + vz]); }
                asm volatile("" ::: "memory"); }
        } else if (type == 1) {
            bf16_t* kd = img + 16384 + d * 64;
#pragma unroll
            for (int t8 = 0; t8 < 8; ++t8) { float v[8];
#pragma unroll
                for (int e = 0; e < 8; ++e) { const int t = 8 * t8 + e; const float kv = x[t] * srk[t + vz]; Kb[t * 136 + d] = (bf16_t)f2bf(kv); v[e] = kv * sek[t + vz]; x[t] = kv * sbeta[t + vz] * seg[t + vz]; }
                u32x4 w; w.x = pk2(v[0], v[1]); w.y = pk2(v[2], v[3]); w.z = pk2(v[4], v[5]); w.w = pk2(v[6], v[7]); *(u32x4*)(kd + 8 * t8) = w;
                asm volatile("" ::: "memory"); }
        } else if (type == 2) {
#pragma unroll
            for (int t8 = 0; t8 < 8; ++t8) {
#pragma unroll
                for (int e = 0; e < 8; ++e) x[8 * t8 + e] *= sbeta[8 * t8 + e + vz];
                asm volatile("" ::: "memory"); }
        }
    }
    LBAR();
    {
        const int it = wave & 3, kind = wave >> 2; const int l15 = lane & 15, q4 = lane >> 4;
        const LAS bf16_t* Ab = kind ? Qb : Kb;
        bf16x8 af[4];
#pragma unroll
        for (int ks = 0; ks < 4; ++ks) af[ks] = *(const LAS bf16x8*)(Ab + (16 * it + l15) * 136 + 32 * ks + 8 * q4);
#pragma unroll 1
        for (int jt = 0; jt < 4; ++jt) {
            f32x4 c = (f32x4){0.f, 0.f, 0.f, 0.f};
            if (jt <= it) {
#pragma unroll
                for (int ks = 0; ks < 4; ++ks) { const bf16x8 bfm = *(const LAS bf16x8*)(Kb + (16 * jt + l15) * 136 + 32 * ks + 8 * q4); c = MFMA16(af[ks], bfm, c); }
            }
            const int j = 16 * jt + l15; const float gj = sgam[j];
            f32x4 val;
#pragma unroll
            for (int r = 0; r < 4; ++r) { const int i = 16 * it + 4 * q4 + r; const float dec = __expf(fminf(sgam[i] - gj, 0.f));
                const float bi = kind ? 1.f : sbeta[i]; const bool keep = kind ? (i >= j) : (i > j);
                val[r] = keep ? bi * c[r] * dec : 0.f; }
            if (kind == 0) {
#pragma unroll
                for (int r = 0; r < 4; ++r) sA[(16 * it + 4 * q4 + r) * 64 + j] = val[r];
            } else {
#pragma unroll
                for (int r = 0; r < 4; ++r) mimg[(16 * it + 4 * q4 + r) * 64 + j] = (bf16_t)f2bf(val[r]);
            }
        }
    }
    LBAR();
    if (type == 1 || type == 2) {
#pragma unroll
        for (int i = 1; i < 64; ++i) { const LAS float* ar = sA + i * 64; f32x2 s01 = (f32x2){0.f, 0.f}, s23 = (f32x2){0.f, 0.f};
#pragma unroll
            for (int j = 0; j + 1 < i; j += 2) { const f32x2 av = (f32x2){ar[j], ar[j + 1]}, xv = (f32x2){x[j], x[j + 1]};
                if ((j & 2) == 0) s01 = __builtin_elementwise_fma(av, xv, s01); else s23 = __builtin_elementwise_fma(av, xv, s23); }
            float tail = 0.f; if (i & 1) tail = ar[i - 1] * x[i - 1];
            x[i] = x[i] - (((s01[0] + s01[1]) + (s23[0] + s23[1])) + tail); }
        if (type == 1) {
#pragma unroll
            for (int t = 0; t < 64; ++t) img[t * 128 + d] = (bf16_t)f2bf(x[t]);
        } else { bf16_t* ut = img + 24576 + d * 64;
#pragma unroll
            for (int t8 = 0; t8 < 8; ++t8) { u32x4 w; w.x = pk2(x[8 * t8], x[8 * t8 + 1]); w.y = pk2(x[8 * t8 + 2], x[8 * t8 + 3]); w.z = pk2(x[8 * t8 + 4], x[8 * t8 + 5]); w.w = pk2(x[8 * t8 + 6], x[8 * t8 + 7]); *(u32x4*)(ut + 8 * t8) = w; }
        }
    }
    LBAR();
}

constexpr int DN_IMG_ELEMS = 2 * 64 * 136 + 2 * 128 * 72 + 64 * 72;
__device__ __forceinline__ void dn_scan_chunked(const Params& p, LAS unsigned char* lds, int bh, int half, int tid, int lane, int wave) {
    const int b = bh >> 2, h = bh & 3;
    const bf16_t* img = (const bf16_t*)p.out + (size_t)bh * 32 * 32768;
    const bf16_t* mimg = (const bf16_t*)(p.ws + WS_YB) + (size_t)bh * 32 * 4096;
    const float* gl = (const float*)(p.ws + WS_GLAST) + bh * 32;
    bf16_t* oraw = (bf16_t*)(p.ws + WS_RA);
    const int l15 = lane & 15, q4 = lane >> 4, cb = half * 4 + (wave & 3);
    const bool active = wave < 4;
    u32x4 preA[9], preB[9];
#define DN_LOAD(pre, nn) do { _Pragma("unroll") for (int i = 0; i < 8; ++i) pre[i] = *(const u32x4*)(img + (size_t)(nn) * 32768 + (size_t)(tid + 512 * i) * 8); \
        pre[8] = *(const u32x4*)(mimg + (size_t)(nn) * 4096 + tid * 8); } while (0)
#define DN_STORE(buf, pre) do { LAS bf16_t* sW_ = (LAS bf16_t*)lds + (buf) * DN_IMG_ELEMS; LAS bf16_t* sQd_ = sW_ + 64 * 136; LAS bf16_t* sKdT_ = sQd_ + 64 * 136; LAS bf16_t* sUT_ = sKdT_ + 128 * 72; LAS bf16_t* sM_ = sUT_ + 128 * 72; \
        _Pragma("unroll") for (int i = 0; i < 8; ++i) { const int ee = tid * 8 + 4096 * (i & 1); \
            LAS bf16_t* dst = (i < 2) ? (sW_ + (ee >> 7) * 136 + (ee & 127)) : (i < 4) ? (sQd_ + (ee >> 7) * 136 + (ee & 127)) : (i < 6) ? (sKdT_ + (ee >> 6) * 72 + (ee & 63)) : (sUT_ + (ee >> 6) * 72 + (ee & 63)); \
            *(LAS u32x4*)dst = pre[i]; } \
        { const int ee = tid * 8; *(LAS u32x4*)(sM_ + (ee >> 6) * 72 + (ee & 63)) = pre[8]; } } while (0)
#define DN_BAR() do { asm volatile("s_waitcnt lgkmcnt(0)" ::: "memory"); __builtin_amdgcn_s_barrier(); asm volatile("" ::: "memory"); } while (0)
    f32x4 S[8];
#pragma unroll
    for (int i = 0; i < 8; ++i) S[i] = (f32x4){0.f, 0.f, 0.f, 0.f};
#define DN_STEP(n, cur) do { if (active) { __builtin_amdgcn_s_setprio(2); \
        const LAS bf16_t* sW = (const LAS bf16_t*)lds + (cur) * DN_IMG_ELEMS; const LAS bf16_t* sQd = sW + 64 * 136; const LAS bf16_t* sKdT = sQd + 64 * 136; const LAS bf16_t* sUT = sKdT + 128 * 72; const LAS bf16_t* sM = sUT + 128 * 72; \
        const float glast = gl[(n)]; \
        bf16x8 Sb[4]; \
        _Pragma("unroll") for (int s_ = 0; s_ < 4; ++s_) Sb[s_] = pack_p(S[2 * s_], S[2 * s_ + 1]); \
        f32x4 Vn[4], O[4]; \
        _Pragma("unroll") for (int rt = 0; rt < 4; ++rt) { \
            f32x4 p1 = (f32x4){0.f, 0.f, 0.f, 0.f}, oo = (f32x4){0.f, 0.f, 0.f, 0.f}; \
            _Pragma("unroll") for (int s_ = 0; s_ < 4; ++s_) { p1 = MFMA16(frag64(sW + (16 * rt + l15) * 136 + 32 * s_ + 4 * q4), Sb[s_], p1); oo = MFMA16(frag64(sQd + (16 * rt + l15) * 136 + 32 * s_ + 4 * q4), Sb[s_], oo); } \
            const s16x4 u4 = *(const LAS s16x4*)(sUT + (16 * cb + l15) * 72 + 16 * rt + 4 * q4); \
            Vn[rt] = (f32x4){bf2f((unsigned short)u4[0]), bf2f((unsigned short)u4[1]), bf2f((unsigned short)u4[2]), bf2f((unsigned short)u4[3])} - p1; O[rt] = oo; } \
        bf16x8 Vb[2]; Vb[0] = pack_p(Vn[0], Vn[1]); Vb[1] = pack_p(Vn[2], Vn[3]); \
        _Pragma("unroll") for (int rt = 0; rt < 4; ++rt) _Pragma("unroll") for (int s2 = 0; s2 < 2; ++s2) O[rt] = MFMA16(frag64(sM + (16 * rt + l15) * 72 + 32 * s2 + 4 * q4), Vb[s2], O[rt]); \
        _Pragma("unroll") for (int dkb = 0; dkb < 8; ++dkb) { f32x4 acc = S[dkb] * glast; \
            _Pragma("unroll") for (int s2 = 0; s2 < 2; ++s2) acc = MFMA16(frag64(sKdT + (16 * dkb + l15) * 72 + 32 * s2 + 4 * q4), Vb[s2], acc); \
            S[dkb] = acc; } \
        _Pragma("unroll") for (int rt = 0; rt < 4; ++rt) _Pragma("unroll") for (int r = 0; r < 4; ++r) oraw[(size_t)(b * 2048 + 64 * (n) + 16 * rt + 4 * q4 + r) * 512 + h * 128 + 16 * cb + l15] = (bf16_t)f2bf(O[rt][r]); \
    __builtin_amdgcn_s_setprio(0); } } while (0)
    DN_LOAD(preA, 0); DN_STORE(0, preA);
    DN_LOAD(preA, 1); DN_LOAD(preB, 2);
    DN_BAR();
#pragma unroll 1
    for (int n = 0; n < 32; n += 2) {
        DN_STORE(1, preA);
        if (n + 3 < 32) DN_LOAD(preA, n + 3);
        DN_STEP(n, 0);
        DN_BAR();
        if (n + 2 < 32) DN_STORE(0, preB);
        if (n + 4 < 32) DN_LOAD(preB, n + 4);
        DN_STEP(n + 1, 1);
        DN_BAR();
    }
#undef DN_STEP
#undef DN_BAR
#undef DN_LOAD
#undef DN_STORE
    float* so = p.out + O_PDS + (size_t)bh * 16384;
    if (active)
#pragma unroll
    for (int dkb = 0; dkb < 8; ++dkb)
#pragma unroll
        for (int r = 0; r < 4; ++r) so[(size_t)(16 * dkb + 4 * q4 + r) * 128 + 16 * cb + l15] = S[dkb][r];
}


template <int K, class F1, int LDA = K>
__device__ __forceinline__ void skinny_sample_gemm(const bf16_t* A  , const bf16_t* Bt  , int bid, int G, int lane, int wave, const F1& f1) {
    const int l15 = lane & 15, q4 = lane >> 4;
    for (int t = bid; t < 256; t += G) {
        const int rg = t >> 3, cgp = t & 7;
        const bf16_t* ap = A + (size_t)(16 * rg + l15) * LDA + 8 * q4;
        const bf16_t* bp = Bt + (size_t)(128 * cgp + 16 * wave + l15) * K + 8 * q4;
        f32x4 acc = (f32x4){0.f, 0.f, 0.f, 0.f};
#pragma unroll 8
        for (int ks = 0; ks < K / 32; ++ks) { const bf16x8 a = *(const bf16x8*)(ap + 32 * ks), b = *(const bf16x8*)(bp + 32 * ks); acc = MFMA16(a, b, acc); }
        const int col = 128 * cgp + 16 * wave + l15;
#pragma unroll
        for (int r = 0; r < 4; ++r) f1(MP + 16 * rg + 4 * q4 + r, col, acc[r]);
    }
}
struct FGateA1 { const bf16_t* Z; bf16_t* t1;
    __device__ __forceinline__ void operator()(int row, int col, float v) const { t1[(size_t)row * 1024 + col] = (bf16_t)f2bf(sigm(bf2f(Z[(size_t)row * NZ + ZGA + col])) * v); } };
struct FGateB1 { const bf16_t* Z; const bf16_t* t1; bf16_t* mix;
    __device__ __forceinline__ void operator()(int row, int col, float v) const { mix[(size_t)row * 1024 + col] = (bf16_t)f2bf(bf2f(t1[(size_t)row * 1024 + col]) + sigm(bf2f(Z[(size_t)row * NZ + ZGB + col])) * v); } };
struct FResX1 { const float* xs; float* h;
    __device__ __forceinline__ void operator()(int row, int col, float v) const { h[(size_t)row * 1024 + col] = xs[(size_t)(row - MP) * 1024 + col] + v; } };
struct FAcc1 { float* h;
    __device__ __forceinline__ void operator()(int row, int col, float v) const { h[(size_t)row * 1024 + col] += v; } };

__device__ __forceinline__ void xattn_stage(LAS unsigned char* lds, const float* kb, const float* vb, int h, int tid) {
    LAS bf16_t* sK = (LAS bf16_t*)lds;
    LAS bf16_t* sVt = (LAS bf16_t*)(lds + 69632);
    const int key = tid >> 1, half = tid & 1;
    const float* kr = kb + ((size_t)key * 4 + h) * 128 + 64 * half;
    const float* vr = vb + ((size_t)key * 4 + h) * 128 + 64 * half;
#pragma unroll
    for (int i = 0; i < 8; ++i) { const f32x4 a = *(const f32x4*)(kr + 8 * i), b2 = *(const f32x4*)(kr + 8 * i + 4);
        u32x4 w; w.x = pk2(a[0], a[1]); w.y = pk2(a[2], a[3]); w.z = pk2(b2[0], b2[1]); w.w = pk2(b2[2], b2[3]);
        *(LAS u32x4*)(sK + key * 136 + 64 * half + 8 * i) = w; }
#pragma unroll
    for (int i = 0; i < 16; ++i) { const f32x4 a = *(const f32x4*)(vr + 4 * i);
#pragma unroll
        for (int e = 0; e < 4; ++e) sVt[(64 * half + 4 * i + e) * 264 + key] = (bf16_t)f2bf(a[e]); }
}
template <int NQB>
__device__ __forceinline__ void xattn_wave(const Params& p, const LAS unsigned char* lds, int rowbase, int nvalid, int h, int lane) {
    const LAS bf16_t* sK = (const LAS bf16_t*)lds;
    const LAS bf16_t* sVt = (const LAS bf16_t*)(lds + 69632);
    const bf16_t* hq = (const bf16_t*)(p.ws + WS_Z + ZO_HQ);
    bf16_t* xo = (bf16_t*)(p.ws + WS_Z + ZO_XO);
    const int l15 = lane & 15, q4 = lane >> 4;
    const int lr = (l15 < nvalid) ? l15 : (nvalid - 1);
    bf16x8 qf[NQB][4];
#pragma unroll
    for (int qb = 0; qb < NQB; ++qb)
#pragma unroll
        for (int ks = 0; ks < 4; ++ks) qf[qb][ks] = *(const bf16x8*)(hq + (size_t)(rowbase + 16 * qb + lr) * 512 + h * 128 + 32 * ks + 8 * q4);
    f32x4 o[8][NQB]; float mrow[NQB], lrow[NQB];
#pragma unroll
    for (int qb = 0; qb < NQB; ++qb) { mrow[qb] = -1e30f; lrow[qb] = 0.f;
#pragma unroll
        for (int db = 0; db < 8; ++db) o[db][qb] = (f32x4){0.f, 0.f, 0.f, 0.f}; }
    for (int kt = 0; kt < 4; ++kt) {
        f32x4 s[4][NQB];
#pragma unroll
        for (int kb = 0; kb < 4; ++kb) {
            const LAS bf16_t* kr = sK + (64 * kt + 16 * kb + l15) * 136 + 8 * q4;
#pragma unroll
            for (int qb = 0; qb < NQB; ++qb) s[kb][qb] = (f32x4){0.f, 0.f, 0.f, 0.f};
#pragma unroll
            for (int ks = 0; ks < 4; ++ks) { const bf16x8 kf = *(const LAS bf16x8*)(kr + 32 * ks);
#pragma unroll
                for (int qb = 0; qb < NQB; ++qb) s[kb][qb] = MFMA16(kf, qf[qb][ks], s[kb][qb]); }
        }
#pragma unroll
        for (int qb = 0; qb < NQB; ++qb) {
            float mx = -1e30f;
#pragma unroll
            for (int kb = 0; kb < 4; ++kb)
#pragma unroll
                for (int r = 0; r < 4; ++r) { const float v = s[kb][qb][r] * 0.08838834764831845f; s[kb][qb][r] = v; mx = fmaxf(mx, v); }
            mx = fmaxf(mx, __shfl_xor(mx, 16)); mx = fmaxf(mx, __shfl_xor(mx, 32));
            const float mn = fmaxf(mrow[qb], mx), alpha = __expf(mrow[qb] - mn); mrow[qb] = mn;
            float ls = lrow[qb] * alpha;
#pragma unroll
            for (int db = 0; db < 8; ++db) o[db][qb] = o[db][qb] * alpha;
#pragma unroll
            for (int kb = 0; kb < 4; ++kb)
#pragma unroll
                for (int r = 0; r < 4; ++r) { const float pv = __expf(s[kb][qb][r] - mn); ls += pv; s[kb][qb][r] = pv; }
            lrow[qb] = ls;
        }
#pragma unroll
        for (int s2 = 0; s2 < 2; ++s2) {
            bf16x8 pb[NQB];
#pragma unroll
            for (int qb = 0; qb < NQB; ++qb) pb[qb] = pack_p(s[2 * s2][qb], s[2 * s2 + 1][qb]);
#pragma unroll
            for (int db = 0; db < 8; ++db) {
                const LAS bf16_t* vr = sVt + (16 * db + l15) * 264 + 64 * kt + 32 * s2 + 4 * q4;
                const s16x4 lo = *(const LAS s16x4*)vr, hi = *(const LAS s16x4*)(vr + 16);
                const bf16x8 vf = __builtin_shufflevector(lo, hi, 0, 1, 2, 3, 4, 5, 6, 7);
#pragma unroll
                for (int qb = 0; qb < NQB; ++qb) o[db][qb] = MFMA16(vf, pb[qb], o[db][qb]);
            }
        }
    }
#pragma unroll
    for (int qb = 0; qb < NQB; ++qb) {
        float lt = lrow[qb]; lt += __shfl_xor(lt, 16); lt += __shfl_xor(lt, 32); const float inv = __builtin_amdgcn_rcpf(lt);
        if (l15 < nvalid) { const size_t row = (size_t)(rowbase + 16 * qb + l15);
#pragma unroll
            for (int db = 0; db < 8; ++db) { u32x2 w; w.x = pk2(o[db][qb][0] * inv, o[db][qb][1] * inv); w.y = pk2(o[db][qb][2] * inv, o[db][qb][3] * inv);
                *(u32x2*)(xo + row * 512 + h * 128 + 16 * db + 4 * q4) = w; } }
    }
}

template <bool FINAL>
__device__ __forceinline__ void rms_pass(const Params& p, const float* g, int gw, int NGW, int lane) {
    bf16_t* hn = (bf16_t*)(p.ws + WS_RA);
    for (int m = gw; m < MT; m += 2 * NGW) {
        const int mb = (m + NGW < MT) ? (m + NGW) : m;
        f32x4* xa = (f32x4*)(p.out + (size_t)m * 1024); f32x4* xb = (f32x4*)(p.out + (size_t)mb * 1024);
        f32x4 va[4], vb[4]; float sa = 0.f, sb = 0.f;
#pragma unroll
        for (int j = 0; j < 4; ++j) { va[j] = xa[lane + 64 * j]; vb[j] = xb[lane + 64 * j]; }
#pragma unroll
        for (int j = 0; j < 4; ++j) { sa += (va[j][0] * va[j][0] + va[j][1] * va[j][1]) + (va[j][2] * va[j][2] + va[j][3] * va[j][3]); sb += (vb[j][0] * vb[j][0] + vb[j][1] * vb[j][1]) + (vb[j][2] * vb[j][2] + vb[j][3] * vb[j][3]); }
#pragma unroll
        for (int o = 1; o < 64; o <<= 1) { sa += __shfl_xor(sa, o); sb += __shfl_xor(sb, o); }
        const float ra = __builtin_amdgcn_rsqf(sa * (1.f / 1024.f) + EPS), rb = __builtin_amdgcn_rsqf(sb * (1.f / 1024.f) + EPS);
#pragma unroll
        for (int j = 0; j < 4; ++j) { const f32x4 gg = ((const f32x4*)g)[lane + 64 * j]; const f32x4 ya = va[j] * ra * gg, yb = vb[j] * rb * gg;
            if constexpr (FINAL) { xa[lane + 64 * j] = ya; if (mb != m) xb[lane + 64 * j] = yb; }
            else { u32x2 w; w.x = pk2(ya[0], ya[1]); w.y = pk2(ya[2], ya[3]); ((u32x2*)(hn + (size_t)m * 1024))[lane + 64 * j] = w;
                   u32x2 w2; w2.x = pk2(yb[0], yb[1]); w2.y = pk2(yb[2], yb[3]); ((u32x2*)(hn + (size_t)mb * 1024))[lane + 64 * j] = w2; } }
    }
}

__device__ __forceinline__ void ffn_gate_chunk(const Params& p, int row_lo, int nrows, int gtid, int GT) {
    const bf16_t* UG = (const bf16_t*)(p.ws + WS_Z + ZO_UG);
    bf16_t* act = (bf16_t*)(p.ws + WS_Z + ZO_UG) + 2816;
    const float* fcw = p.in[27]; const float* sfc = p.in[9];
    const int np = (row_lo + nrows > MP) ? (MP - row_lo) : nrows;
    for (int it = gtid; it < (np >> 3) * 352; it += GT) {
        const int lr0 = (it / 352) * 8, c = (it % 352) * 8, t0 = (row_lo + lr0) & 2047, bs = (row_lo + lr0) >> 11;
        const bf16_t* ub = UG + (size_t)lr0 * 5632 + c;
        u32x4 uu[8], gg[8], h1 = (u32x4){0u, 0u, 0u, 0u}, h0 = (u32x4){0u, 0u, 0u, 0u};
        if (t0 != 0) { h1 = *(const u32x4*)(ub - 5632); h0 = *(const u32x4*)(ub - 2 * 5632); }
#pragma unroll
        for (int i = 0; i < 8; ++i) { uu[i] = *(const u32x4*)(ub + (size_t)i * 5632); gg[i] = *(const u32x4*)(ub + (size_t)i * 5632 + 2816); }
        const f32x4 wa0 = *(const f32x4*)(fcw + c), wa1 = *(const f32x4*)(fcw + c + 4), wb0 = *(const f32x4*)(fcw + 2816 + c), wb1 = *(const f32x4*)(fcw + 2816 + c + 4), wc0 = *(const f32x4*)(fcw + 2 * 2816 + c), wc1 = *(const f32x4*)(fcw + 2 * 2816 + c + 4);
#pragma unroll
        for (int i = 0; i < 8; ++i) {
            const u32x4 x2 = uu[i]; u32x4 o;
#pragma unroll
            for (int w = 0; w < 4; ++w) {
                const float k0 = (w < 2) ? wa0[2 * (w & 1)] : wa1[2 * (w & 1)], k0b = (w < 2) ? wa0[2 * (w & 1) + 1] : wa1[2 * (w & 1) + 1];
                const float k1 = (w < 2) ? wb0[2 * (w & 1)] : wb1[2 * (w & 1)], k1b = (w < 2) ? wb0[2 * (w & 1) + 1] : wb1[2 * (w & 1) + 1];
                const float k2 = (w < 2) ? wc0[2 * (w & 1)] : wc1[2 * (w & 1)], k2b = (w < 2) ? wc0[2 * (w & 1) + 1] : wc1[2 * (w & 1) + 1];
                const float ya = k0 * bflo(h0[w]) + k1 * bflo(h1[w]) + k2 * bflo(x2[w]), yb2 = k0b * bfhi(h0[w]) + k1b * bfhi(h1[w]) + k2b * bfhi(x2[w]);
                o[w] = pk2(silu(ya) * bflo(gg[i][w]), silu(yb2) * bfhi(gg[i][w])); }
            *(u32x4*)(act + (size_t)(row_lo + lr0 + i) * 5632 + c) = o;
            if (t0 + i >= 2046) { float* od = p.out + O_PFC + ((size_t)bs * 2 + (t0 + i - 2046)) * 2816 + c;
                *(f32x4*)od = (f32x4){bflo(x2[0]), bfhi(x2[0]), bflo(x2[1]), bfhi(x2[1])}; *(f32x4*)(od + 4) = (f32x4){bflo(x2[2]), bfhi(x2[2]), bflo(x2[3]), bfhi(x2[3])}; }
            h0 = h1; h1 = x2;
        }
    }
    const int items = (nrows - np) * 352;
    for (int it = gtid; it < items; it += GT) {
        const int lr = np + it / 352, c = (it % 352) * 8, r = row_lo + lr;
        const bool samp = true; const int t = (r - MP) & 3; const int bs = (r - MP) >> 2;
        const u32x4 u0 = *(const u32x4*)(UG + (size_t)lr * 5632 + c), gv = *(const u32x4*)(UG + (size_t)lr * 5632 + 2816 + c);
        float x0[8], x1[8], x2[8], gvf[8];
#pragma unroll
        for (int w = 0; w < 4; ++w) { x2[2 * w] = bflo(u0[w]); x2[2 * w + 1] = bfhi(u0[w]); gvf[2 * w] = bflo(gv[w]); gvf[2 * w + 1] = bfhi(gv[w]); }
        if (t >= 1) { const u32x4 a = *(const u32x4*)(UG + (size_t)(lr - 1) * 5632 + c);
#pragma unroll
            for (int w = 0; w < 4; ++w) { x1[2 * w] = bflo(a[w]); x1[2 * w + 1] = bfhi(a[w]); } }
        else { const float* s = sfc + ((size_t)bs * 2 + 1) * 2816 + c;
#pragma unroll
            for (int e = 0; e < 8; ++e) x1[e] = s[e]; }
        if (t >= 2) { const u32x4 a = *(const u32x4*)(UG + (size_t)(lr - 2) * 5632 + c);
#pragma unroll
            for (int w = 0; w < 4; ++w) { x0[2 * w] = bflo(a[w]); x0[2 * w + 1] = bfhi(a[w]); } }
        else { const float* s = sfc + ((size_t)bs * 2 + t) * 2816 + c;
#pragma unroll
            for (int e = 0; e < 8; ++e) x0[e] = s[e]; }
        float a8[8];
#pragma unroll
        for (int e = 0; e < 8; ++e) { const float y = fcw[c + e] * x0[e] + fcw[2816 + c + e] * x1[e] + fcw[2 * 2816 + c + e] * x2[e]; a8[e] = silu(y) * gvf[e]; }
        u32x4 o; o.x = pk2(a8[0], a8[1]); o.y = pk2(a8[2], a8[3]); o.z = pk2(a8[4], a8[5]); o.w = pk2(a8[6], a8[7]);
        *(u32x4*)(act + (size_t)(row_lo + lr) * 5632 + c) = o;
        if (samp && t >= 2) { float* od = p.out + O_SFC + ((size_t)bs * 2 + (t - 2)) * 2816 + c;
            *(f32x4*)od = (f32x4){x2[0], x2[1], x2[2], x2[3]}; *(f32x4*)(od + 4) = (f32x4){x2[4], x2[5], x2[6], x2[7]}; }
    }
}

#define XB_TMO      128
#define XB_XCNT(j)  (256  + 64 * (j))
#define XB_XSUB(j)  (1280 + 64 * (j))
#define XB_XGEN(j)  (2304 + 64 * (j))
#define XB_TOP      3328
#define XB_TOPGEN   3392
#define XCD_BAR_WORDS 3456
#define XB_SPIN_CAP (1u << 18)

__device__ __forceinline__ unsigned xb_ld(unsigned* p)              { return __hip_atomic_load(p, __ATOMIC_RELAXED, __HIP_MEMORY_SCOPE_AGENT); }
__device__ __forceinline__ unsigned xb_add(unsigned* p, unsigned v) { return __hip_atomic_fetch_add(p, v, __ATOMIC_RELAXED, __HIP_MEMORY_SCOPE_AGENT); }
__device__ __forceinline__ unsigned xb_xcc_id() { return (unsigned)__builtin_amdgcn_s_getreg((3 << 11) | 20) & 0xFu; }
#define XB_SPIN(cond, bar) do { unsigned _sp = 0; while (cond) { __builtin_amdgcn_s_sleep(1); \
    if ((++_sp & 255u) == 0u) { if (xb_ld(&(bar)[XB_TMO])) break; if (_sp > XB_SPIN_CAP) { atomicAdd(&(bar)[XB_TMO], 1u); break; } } } } while (0)

struct XcdBarrier {
    unsigned* bar; unsigned x;
    volatile LAS unsigned* st;
};

__device__ __forceinline__ XcdBarrier xcd_barrier_post(unsigned* bar, volatile LAS unsigned* st) {
    XcdBarrier b; b.bar = bar; b.x = xb_xcc_id(); b.st = st;
    if (threadIdx.x == 0) (void)xb_add(&bar[XB_XCNT(b.x)], 1u);
    return b;
}
__device__ __forceinline__ void xcd_barrier_complete(unsigned* bar, unsigned x, unsigned& nloc, unsigned& nx) {
    const unsigned G = gridDim.x * gridDim.y * gridDim.z;
    unsigned sum, cnt, mine, sp = 0u;
    for (;;) {
        sum = 0u; cnt = 0u; mine = 0u;
#pragma unroll
        for (unsigned j = 0; j < 16; ++j) { const unsigned c = xb_ld(&bar[XB_XCNT(j)]); sum += c; cnt += (c > 0u) ? 1u : 0u; mine = (j == x) ? c : mine; }
        if (sum == G) break;
        __builtin_amdgcn_s_sleep(1);
        if ((++sp & 255u) == 0u) { if (xb_ld(&bar[XB_TMO])) break; if (sp > XB_SPIN_CAP) { atomicAdd(&bar[XB_TMO], 1u); break; } }
    }
    nloc = mine > 0u ? mine : 1u; nx = cnt > 0u ? cnt : 1u;
}

__device__ __attribute__((noinline)) void xcd_barrier(unsigned* bar_, unsigned x_, volatile LAS unsigned* st_) {
    XcdBarrier b; b.bar = bar_; b.x = x_; b.st = st_;
    asm volatile("s_waitcnt vmcnt(0)" ::: "memory");
    __syncthreads();
    if (threadIdx.x == 0) {
        unsigned* bar = b.bar;
        __builtin_amdgcn_s_waitcnt(0);
        unsigned nloc = b.st[0], nx = b.st[1];
        if (nloc == 0u) { xcd_barrier_complete(bar, b.x, nloc, nx); b.st[0] = nloc; b.st[1] = nx; }
        const unsigned old = xb_add(&bar[XB_XSUB(b.x)], 1u);
        const unsigned gen = old / nloc;
        if (old + 1u == (gen + 1u) * nloc) {
            __builtin_amdgcn_fence(__ATOMIC_RELEASE, "agent");
            asm volatile("s_waitcnt vmcnt(0)" ::: "memory");
            const unsigned og = xb_add(&bar[XB_TOP], 1u);
            const unsigned tg = og / nx;
            if (og + 1u == (tg + 1u) * nx) xb_add(&bar[XB_TOPGEN], 1u);
            else XB_SPIN(xb_ld(&bar[XB_TOPGEN]) == tg, bar);
            __builtin_amdgcn_fence(__ATOMIC_ACQUIRE, "agent");
            xb_add(&bar[XB_XGEN(b.x)], 1u);
            asm volatile("s_waitcnt vmcnt(0)" ::: "memory");
        } else {
            XB_SPIN(xb_ld(&bar[XB_XGEN(b.x)]) == gen, bar);
            __builtin_amdgcn_fence(__ATOMIC_ACQUIRE, "agent");
            asm volatile("s_waitcnt vmcnt(0)" ::: "memory");
        }
    }
    __syncthreads();
}

__global__ void __launch_bounds__(NTHR, 2) mega_fwd(Params p) {
    extern __shared__ __attribute__((aligned(16))) unsigned char lds_raw[];
    LAS unsigned char* lds = (LAS unsigned char*)lds_raw;
    cg::grid_group grid = cg::this_grid();
#define PH_IDS() int tid = threadIdx.x; asm volatile("" : "+v"(tid)); const int lane = tid & 63, wave = __builtin_amdgcn_readfirstlane(tid >> 6); \
    const int G = gridDim.x, bid = blockIdx.x; const int gw = bid * 8 + wave, NGW = G * 8, gtid = bid * NTHR + tid, GT = G * NTHR; \
    unsigned char* ws = p.ws; bf16_t* RA = (bf16_t*)(ws + WS_RA); bf16_t* Zb = (bf16_t*)(ws + WS_Z); float* hres = p.out; \
    (void)lane; (void)wave; (void)G; (void)bid; (void)gw; (void)NGW; (void)gtid; (void)GT; (void)RA; (void)Zb; (void)hres
#define BST() ((volatile LAS unsigned*)(lds + LDS_BYTES - 16))
#define GSYNC() xcd_barrier((unsigned*)(p.ws + WS_CTL), xb_xcc_id(), BST())
    {
        if (threadIdx.x == 0) { BST()[0] = 0u; BST()[1] = 0u; }
        __syncthreads();
        (void)xcd_barrier_post((unsigned*)(p.ws + WS_CTL), BST());
    }

    { PH_IDS();
    p0_prologue(p, lds, tid, lane, wave, G);
    }
    GSYNC();

    { PH_IDS();
    { pg8::Gemm g{RA, (const bf16_t*)(ws + WS_WIN), MT, NZ, 1024, 1024}; pg8::StaticOrder S; S.init(MT, NZ, G, bid);
      pg8::EpiBf16 E{Zb, NZ};
      pg8::gemm_phase<pg8::EpiBf16, pg8::StaticOrder, true, true>(lds, g, S, E); }
    { const int tb1 = (G == 256) ? 230 : 0;
      if (bid >= tb1) { LAS float* scr = (LAS float*)(lds + wave * 16384);
        constexpr int J5 = 16 * 32, J6 = 16 * 16, J3 = 8 * 32;
        for (int it = (bid - tb1) * 8 + wave; it < J5 + J6 + J5 + J3; it += (G - tb1) * 8) { int r = it;
            if (r < J5) { transpose_item(p.in[19], 1024, 0, 1024, 1024, (bf16_t*)(ws + WS_WMO), 0, scr, r, lane); continue; } r -= J5;
            if (r < J6) { transpose_item(p.in[22], 512, 0, 1024, 512, (bf16_t*)(ws + WS_WXQ), 0, scr, r, lane); continue; } r -= J6;
            if (r < J5) { transpose_item(p.in[23], 1024, 0, 1024, 1024, (bf16_t*)(ws + WS_WXKV), 0, scr, r, lane); continue; } r -= J5;
            transpose_item(p.in[24], 1024, 0, 512, 1024, (bf16_t*)(ws + WS_WXO), 0, scr, r, lane); } } }
    }
    GSYNC();

    { PH_IDS();
    for (int u = bid; u < 1024; u += G) dn_chunk_prep(p, lds, u, tid, lane, wave);
    }
    GSYNC();

    { PH_IDS();
    {
        const int nA = (G >= 128) ? 64 : G / 2;
        if (bid < nA) {
            for (int it = bid; it < 64; it += nA) dn_scan_chunked(p, lds, (it & 7) + 8 * (it >> 4), (it >> 3) & 1, tid, lane, wave);
        } else {
            const int idx = bid - nA, nB = G - nA;
            for (int it = idx; it < 256; it += nB) swa_prompt_item(p, lds, it, tid, lane, wave);
            const int ridx = nB - 1 - idx;
            for (int it = ridx; it < 256; it += nB) swa_sample_item(p, lds, it, tid);
            for (int it = ridx; it < 512; it += nB) { const int h = it & 3, s = it >> 2;
                dn_scan_item<128, 4, 4>(p, lds, MP + 4 * s, 4, h, 0, p.in[6] + (size_t)(s * 4 + h) * 16384, p.in[5] + (size_t)s * 3 * 1536, p.out + O_SDS + (size_t)(s * 4 + h) * 16384, tid); }
        }
    }
    }
    GSYNC();

    { PH_IDS();
    {
        const bf16_t* oraw = (const bf16_t*)(ws + WS_RA); const float* gn = p.in[15]; bf16_t* yb = (bf16_t*)(ws + WS_YB);
        {
            const int c8 = (lane & 15) * 8, ch = (lane >> 4) * 128 + c8;
            const f32x4 g0 = *(const f32x4*)(gn + c8), g1 = *(const f32x4*)(gn + c8 + 4);
            for (int m = gw; m < MT; m += 2 * NGW) {
                const int mb = (m + NGW < MT) ? (m + NGW) : m;
                const u32x4 oa = *(const u32x4*)(oraw + (size_t)m * 512 + ch), ob = *(const u32x4*)(oraw + (size_t)mb * 512 + ch);
                const f32x4 a0 = (f32x4){bflo(oa.x), bfhi(oa.x), bflo(oa.y), bfhi(oa.y)}, a1 = (f32x4){bflo(oa.z), bfhi(oa.z), bflo(oa.w), bfhi(oa.w)};
                const f32x4 b0 = (f32x4){bflo(ob.x), bfhi(ob.x), bflo(ob.y), bfhi(ob.y)}, b1 = (f32x4){bflo(ob.z), bfhi(ob.z), bflo(ob.w), bfhi(ob.w)};
                const u32x4 za = *(const u32x4*)(Zb + (size_t)m * NZ + ZDZ + ch), zb = *(const u32x4*)(Zb + (size_t)mb * NZ + ZDZ + ch);
                float sa = (a0[0] * a0[0] + a0[1] * a0[1]) + (a0[2] * a0[2] + a0[3] * a0[3]) + (a1[0] * a1[0] + a1[1] * a1[1]) + (a1[2] * a1[2] + a1[3] * a1[3]);
                float sb = (b0[0] * b0[0] + b0[1] * b0[1]) + (b0[2] * b0[2] + b0[3] * b0[3]) + (b1[0] * b1[0] + b1[1] * b1[1]) + (b1[2] * b1[2] + b1[3] * b1[3]);
#pragma unroll
                for (int o = 1; o < 16; o <<= 1) { sa += __shfl_xor(sa, o); sb += __shfl_xor(sb, o); }
                const float ra = __builtin_amdgcn_rsqf(sa * (1.f / 128.f) + EPS), rb = __builtin_amdgcn_rsqf(sb * (1.f / 128.f) + EPS);
                u32x4 wa, wb;
                wa.x = pk2(a0[0] * ra * g0[0] * silu(bflo(za.x)), a0[1] * ra * g0[1] * silu(bfhi(za.x))); wa.y = pk2(a0[2] * ra * g0[2] * silu(bflo(za.y)), a0[3] * ra * g0[3] * silu(bfhi(za.y)));
                wa.z = pk2(a1[0] * ra * g1[0] * silu(bflo(za.z)), a1[1] * ra * g1[1] * silu(bfhi(za.z))); wa.w = pk2(a1[2] * ra * g1[2] * silu(bflo(za.w)), a1[3] * ra * g1[3] * silu(bfhi(za.w)));
                wb.x = pk2(b0[0] * rb * g0[0] * silu(bflo(zb.x)), b0[1] * rb * g0[1] * silu(bfhi(zb.x))); wb.y = pk2(b0[2] * rb * g0[2] * silu(bflo(zb.y)), b0[3] * rb * g0[3] * silu(bfhi(zb.y)));
                wb.z = pk2(b1[0] * rb * g1[0] * silu(bflo(zb.z)), b1[1] * rb * g1[1] * silu(bfhi(zb.z))); wb.w = pk2(b1[2] * rb * g1[2] * silu(bflo(zb.w)), b1[3] * rb * g1[3] * silu(bfhi(zb.w)));
                *(u32x4*)(yb + (size_t)m * 512 + ch) = wa; *(u32x4*)(yb + (size_t)mb * 512 + ch) = wb;
            }
        }
        for (int e = gtid; e < 8 * 3 * 1536; e += GT) { const int cc = e % 1536, r = (e / 1536) % 3, b = e / (3 * 1536);
            p.out[O_PDC + e] = bf2f(Zb[(size_t)(b * 2048 + 2045 + r) * NZ + ZDQ + cc]); }
        for (int e = gtid; e < 128 * 3 * 1536; e += GT) { const int cc = e % 1536, r = (e / 1536) % 3, b = e / (3 * 1536);
            p.out[O_SDC + e] = bf2f(Zb[(size_t)(MP + 4 * b + 1 + r) * NZ + ZDQ + cc]); }
        pg8::Gemm g{(const bf16_t*)(ws + WS_YA), (const bf16_t*)(ws + WS_WA), MP, 1024, 512, 512}; pg8::StaticOrder S; S.init(MP, 1024, G, bid);
        pg8::EpiF8P<FGateA8> E{FGateA8{Zb, (bf16_t*)hres}};
        pg8::gemm_phase<pg8::EpiF8P<FGateA8>, pg8::StaticOrder, true, true>(lds, g, S, E);
        skinny_sample_gemm<512>((const bf16_t*)(ws + WS_YA) + (size_t)MP * 512, (const bf16_t*)(ws + WS_WA), bid, G, lane, wave, FGateA1{Zb, (bf16_t*)hres});
    }
    }
    GSYNC();

    { PH_IDS();
    { pg8::Gemm g{(const bf16_t*)(ws + WS_YB), (const bf16_t*)(ws + WS_WB), MP, 1024, 512, 512}; pg8::StaticOrder S; S.init(MP, 1024, G, bid);
      pg8::EpiF8P<FGateB8> E{FGateB8{Zb, (const bf16_t*)hres, RA}};
      pg8::gemm_phase<pg8::EpiF8P<FGateB8>, pg8::StaticOrder, true, true>(lds, g, S, E);
      skinny_sample_gemm<512>((const bf16_t*)(ws + WS_YB) + (size_t)MP * 512, (const bf16_t*)(ws + WS_WB), bid, G, lane, wave, FGateB1{Zb, (const bf16_t*)hres, RA}); }
    }
    GSYNC();

    { PH_IDS();
    { pg8::Gemm g{RA, (const bf16_t*)(ws + WS_WMO), MP, 1024, 1024, 1024}; pg8::StaticOrder S; S.init(MP, 1024, G, bid);
      pg8::EpiF8P<FResX8> E{FResX8{p.in[0], hres}};
      pg8::gemm_phase<pg8::EpiF8P<FResX8>, pg8::StaticOrder, true, true>(lds, g, S, E);
      skinny_sample_gemm<1024>(RA + (size_t)MP * 1024, (const bf16_t*)(ws + WS_WMO), bid, G, lane, wave, FResX1{p.in[1], hres}); }
    }
    GSYNC();

    { PH_IDS();
    rms_pass<false>(p, p.in[20], gw, NGW, lane);
    }
    GSYNC();

    { PH_IDS();
    { pg8::Gemm g{RA, (const bf16_t*)(ws + WS_WXQ), MT, 512, 1024, 1024}; pg8::StaticOrder S; S.init(MT, 512, G, bid);
      pg8::EpiBf16 E{(bf16_t*)(ws + WS_Z + ZO_HQ), 512};
      pg8::gemm_phase<pg8::EpiBf16, pg8::StaticOrder, true, true>(lds, g, S, E); }
    const int tb0 = (G > 200) ? 168 : 0;
    if (bid >= tb0) {
      LAS float* scr = (LAS float*)(lds + wave * 16384);
      constexpr int J9 = 16 * 176, J10 = 44 * 32;
      for (int it = (bid - tb0) * 8 + wave; it < J9 + J10; it += (G - tb0) * 8) {
          if (it < J9) transpose_item(p.in[26], 5632, 0, 1024, 5632, (bf16_t*)(ws + WS_WUP), 0, scr, it, lane);
          else transpose_item(p.in[28], 1024, 0, 2816, 1024, (bf16_t*)(ws + WS_WDN), 0, scr, it - J9, lane); }
    }
    if (bid >= 136) {
      pg8::Gemm g{(const bf16_t*)(ws + WS_MEMN), (const bf16_t*)(ws + WS_WXKV), 2048, 1024, 1024, 1024}; pg8::StaticOrder S; S.init(2048, 1024, G - 136, bid - 136);
      pg8::EpiF<FMem> E{FMem{p.out + O_PMK, p.out + O_PMV}};
      pg8::gemm_phase<pg8::EpiF<FMem>, pg8::StaticOrder, true, true>(lds, g, S, E); }
    }
    GSYNC();

    { PH_IDS();
    {
        for (int it = bid; it < 256; it += G) { const int xcd = it & 7, slot = it >> 3, bh_ = xcd * 4 + (slot >> 3), qblk = slot & 7, h = bh_ & 3, b = bh_ >> 2;
            xattn_stage(lds, p.out + O_PMK + (size_t)b * 256 * 512, p.out + O_PMV + (size_t)b * 256 * 512, h, tid);
            LBAR();
            xattn_wave<2>(p, lds, b * 2048 + qblk * 256 + 32 * wave, 16, h, lane);
            LBAR(); }
        for (int it = bid; it < 512; it += G) { const int h = it & 3, s = it >> 2;
            xattn_stage(lds, p.in[7] + (size_t)s * 256 * 512, p.in[8] + (size_t)s * 256 * 512, h, tid);
            LBAR();
            if (wave == 0) xattn_wave<1>(p, lds, MP + 4 * s, 4, h, lane);
            LBAR(); }
    }
    }
    GSYNC();

    { PH_IDS();
    { pg8::Gemm g{(const bf16_t*)(ws + WS_Z + ZO_XO), (const bf16_t*)(ws + WS_WXO), MP, 1024, 512, 512}; pg8::StaticOrder S; S.init(MP, 1024, G, bid);
      pg8::EpiF8P<FAcc8> E{FAcc8{hres}};
      pg8::gemm_phase<pg8::EpiF8P<FAcc8>, pg8::StaticOrder, true, true>(lds, g, S, E);
      skinny_sample_gemm<512>((const bf16_t*)(ws + WS_Z + ZO_XO) + (size_t)MP * 512, (const bf16_t*)(ws + WS_WXO), bid, G, lane, wave, FAcc1{hres}); }
    }
    GSYNC();

    { PH_IDS();
    rms_pass<false>(p, p.in[25], gw, NGW, lane);
    }
    GSYNC();

    { PH_IDS();
    { pg8::Gemm g{RA, (const bf16_t*)(ws + WS_WUP), MT, 5632, 1024, 1024}; pg8::StaticOrder S; S.init(MT, 5632, G, bid);
      pg8::EpiBf16 E{(bf16_t*)(ws + WS_Z + ZO_UG), 5632};
      pg8::gemm_phase<pg8::EpiBf16, pg8::StaticOrder, true, true>(lds, g, S, E); }
    GSYNC();
    ffn_gate_chunk(p, 0, MT, gtid, GT);
    GSYNC();
    { pg8::Gemm g{(const bf16_t*)(ws + WS_Z + ZO_UG) + 2816, (const bf16_t*)(ws + WS_WDN), MP, 1024, 2816, 5632, 2816}; pg8::StaticOrder S; S.init(MP, 1024, G, bid);
      pg8::EpiF8P<FAcc8> E{FAcc8{hres}};
      pg8::gemm_phase<pg8::EpiF8P<FAcc8>, pg8::StaticOrder, true, true>(lds, g, S, E); }
    skinny_sample_gemm<2816, FAcc1, 5632>((const bf16_t*)(ws + WS_Z + ZO_UG) + 2816 + (size_t)MP * 5632, (const bf16_t*)(ws + WS_WDN), bid, G, lane, wave, FAcc1{hres});
    }
    GSYNC();

    { PH_IDS();
    rms_pass<true>(p, p.in[29], gw, NGW, lane);
    }
    if (p.ws == nullptr) grid.sync();
}


extern "C" void kernel_launch(void* const* d_in, const int* in_sizes, int n_in, void* d_out, int out_size, void* d_ws, size_t ws_size, hipStream_t stream) {
    static int grid = 0;
    if (grid == 0) {
        if (n_in != 30 || (size_t)out_size != O_END || ws_size < WS_END) { fprintf(stderr, "kernel_launch: unexpected shapes (n_in %d, out %d, ws %zu, need %zu)\n", n_in, out_size, ws_size, (size_t)WS_END); grid = -1; return; }
        int dev = 0, cus = 0, per_cu = 0;
        (void)hipGetDevice(&dev);
        (void)hipDeviceGetAttribute(&cus, hipDeviceAttributeMultiprocessorCount, dev);
        (void)hipFuncSetAttribute((const void*)mega_fwd, hipFuncAttributeMaxDynamicSharedMemorySize, LDS_BYTES);
        if (hipOccupancyMaxActiveBlocksPerMultiprocessor(&per_cu, (const void*)mega_fwd, NTHR, LDS_BYTES) != hipSuccess || per_cu < 1) { fprintf(stderr, "kernel_launch: occupancy query says %d\n", per_cu); per_cu = 1; }
        (void)hipGetLastError();
        grid = cus * 1;
        if (grid <= 0) grid = 256;
    }
    if (grid < 0) return;
    Params p{};
    for (int i = 0; i < 30; ++i) p.in[i] = (const float*)d_in[i];
    p.out = (float*)d_out; p.ws = (unsigned char*)d_ws;
    for (int i = 0; i < 8; ++i) p.inv[i] = pow(500000.0, -(double)i / 8.0);
    (void)hipMemsetAsync((char*)d_ws + WS_CTL, 0, 16384, stream);
    void* args[] = {&p};
    hipError_t e = hipLaunchCooperativeKernel((void*)mega_fwd, dim3(grid), dim3(NTHR), args, LDS_BYTES, stream);
    if (e != hipSuccess) fprintf(stderr, "cooperative launch failed: %s (grid %d)\n", hipGetErrorString(e), grid);
}
```

```cpp
#include <hip/hip_runtime.h>
#include <hip/hip_cooperative_groups.h>
#include <cstdio>
#include <cstdint>
#include <cmath>
namespace cg = cooperative_groups;

namespace pg8 {
#define PG8_LAS __attribute__((address_space(3)))
typedef unsigned short bf16_t;
typedef short bf16x8 __attribute__((ext_vector_type(8)));
typedef float f32x4 __attribute__((ext_vector_type(4)));
typedef unsigned u32x4 __attribute__((ext_vector_type(4)));
constexpr int BM = 256, BK = 64, HALF = 128, HTB = HALF * BK * 2  , STAGE_BYTES = 8 * HTB, NXCD = 8, WGM = 3;

__host__ __device__ __forceinline__ int lds_byte(int r, int c) { const int st = (r >> 4) * 2 + (c >> 5), rr = r & 15, cc = c & 31, ob = rr * 64 + cc * 2; return st * 1024 + (ob ^ (((ob >> 9) & 1) << 5)); }
__host__ __device__ __forceinline__ void stage_rc(int b, int& R, int& C) { const int st = b / 1024, sb = b % 1024, swz = sb ^ (((sb >> 9) & 1) << 5); R = (st >> 1) * 16 + swz / 64; C = (st & 1) * 32 + (swz % 64) / 2; }
__host__ __device__ __forceinline__ int perm32(int rho) { const int n = rho >> 4, i = rho & 15; return 8 * (i >> 2) + 4 * n + (i & 3); }

struct Unit { int pm, pn, k0; };
struct Gemm { const bf16_t* A; const bf16_t* Bt; int M, N, K, ld, ldb; };

struct StaticOrder {
    int nM, nN, nwg, G, c;
    __host__ __device__ void init(int M, int N, int G_, int c_) { nM = M / BM; nN = N / BM; nwg = nM * nN; G = G_; c = c_; }
    __host__ __device__ bool next(int i, Unit& u) const {
        const long L = (long)i * G + c; if (L >= nwg) return false;
        int wgid = (int)L; { const int q = nwg / NXCD, r = nwg % NXCD, xcd = wgid % NXCD, off = wgid / NXCD; wgid = (xcd < r ? xcd * (q + 1) : r * (q + 1) + (xcd - r) * q) + off; }
        const int nig = WGM * nN, gid = wgid / nig, fm = gid * WGM, gsz = (nM - fm) < WGM ? (nM - fm) : WGM;
        u.pm = fm + ((wgid % nig) % gsz); u.pn = (wgid % nig) / gsz; u.k0 = 0; return true;
    }
    __device__ __forceinline__ void a_ready(const Unit&) const {}
    __device__ __forceinline__ void done(const Unit&) const {}
};

template <int NSL, int KLEN, int PM0> struct SliceOrder {
    int c;
    __device__ __forceinline__ bool next(int i, Unit& u) const { if (i != 0 || c >= 8 * NSL) return false; const int u8 = c / NSL, sl = c % NSL;
        u.pm = __builtin_amdgcn_readfirstlane(PM0 + (u8 >> 2)); u.pn = __builtin_amdgcn_readfirstlane(u8 & 3); u.k0 = __builtin_amdgcn_readfirstlane(sl * KLEN); return true; }
    __device__ __forceinline__ void a_ready(const Unit&) const {}
    __device__ __forceinline__ void done(const Unit&) const {}
};
__device__ __forceinline__ unsigned cvt_pk_bf16(float lo, float hi) { unsigned r; asm volatile("v_cvt_pk_bf16_f32 %0, %1, %2" : "=v"(r) : "v"(lo), "v"(hi)); return r; }
typedef unsigned u32x2 __attribute__((ext_vector_type(2)));
struct EpiBf16 {
    static constexpr bool PERM = true, AFTER_DRAIN = false;
    bf16_t* O; int ldc;
    __device__ __forceinline__ void operator()(const f32x4 (&acc)[2][2][4][2], const Unit& u, int wr, int wc, int fr, int fq) const {
        const int row0 = u.pm * BM + wr * 64 + fr; const int col0 = u.pn * BM + wc * 32 + 8 * fq;
#pragma unroll
        for (int ai = 0; ai < 2; ++ai)
#pragma unroll
            for (int m = 0; m < 4; ++m) { bf16_t* rowp = O + (size_t)(row0 + ai * HALF + m * 16) * ldc + col0;
#pragma unroll
                for (int bj = 0; bj < 2; ++bj) { const f32x4 v0 = acc[ai][bj][m][0], v1 = acc[ai][bj][m][1];
                    u32x4 w; w.x = cvt_pk_bf16(v0[0], v0[1]); w.y = cvt_pk_bf16(v0[2], v0[3]); w.z = cvt_pk_bf16(v1[0], v1[1]); w.w = cvt_pk_bf16(v1[2], v1[3]);
                    *(u32x4*)(rowp + bj * HALF) = w; } }
    }
};
template <class F> struct EpiF8 {
    static constexpr bool PERM = true, AFTER_DRAIN = false;
    F f;
    __device__ __forceinline__ void operator()(const f32x4 (&acc)[2][2][4][2], const Unit& u, int wr, int wc, int fr, int fq) const {
        asm volatile("" : "+v"(fr), "+v"(fq));
#pragma unroll
        for (int ai = 0; ai < 2; ++ai)
#pragma unroll
            for (int m = 0; m < 4; ++m) { const int row = u.pm * BM + ai * HALF + wr * 64 + m * 16 + fr;
#pragma unroll
                for (int bj = 0; bj < 2; ++bj) f(row, u.pn * BM + bj * HALF + wc * 32 + 8 * fq, acc[ai][bj][m][0], acc[ai][bj][m][1]); }
    }
};
template <class F> struct EpiF8P {
    static constexpr bool PERM = true, AFTER_DRAIN = false;
    F f;
    __device__ __forceinline__ void operator()(const f32x4 (&acc)[2][2][4][2], const Unit& u, int wr, int wc, int fr, int fq) const {
        asm volatile("" : "+v"(fr), "+v"(fq));
        const int col0 = u.pn * BM + wc * 32 + 8 * fq;
#pragma unroll
        for (int ai = 0; ai < 2; ++ai)
#pragma unroll
        for (int mh = 0; mh < 2; ++mh) {
            const int row0 = u.pm * BM + ai * HALF + wr * 64 + mh * 32 + fr;
            typename F::L ld[2][2];
#pragma unroll
            for (int m = 0; m < 2; ++m)
#pragma unroll
                for (int bj = 0; bj < 2; ++bj) ld[m][bj] = f.load(row0 + m * 16, col0 + bj * HALF);
#pragma unroll
            for (int m = 0; m < 2; ++m)
#pragma unroll
                for (int bj = 0; bj < 2; ++bj) f.apply(row0 + m * 16, col0 + bj * HALF, acc[ai][bj][2 * mh + m][0], acc[ai][bj][2 * mh + m][1], ld[m][bj]);
        }
    }
};
template <class F> struct EpiF {
    static constexpr bool PERM = false, AFTER_DRAIN = false;
    F f;
    __device__ __forceinline__ void operator()(const f32x4 (&acc)[2][2][4][2], const Unit& u, int wr, int wc, int fr, int fq) const {
        asm volatile("" : "+v"(fr), "+v"(fq));
#pragma unroll
        for (int ai = 0; ai < 2; ++ai)
#pragma unroll
            for (int m = 0; m < 4; ++m) { const int row = u.pm * BM + ai * HALF + wr * 64 + m * 16 + fr;
#pragma unroll
                for (int bj = 0; bj < 2; ++bj)
#pragma unroll
                    for (int n = 0; n < 2; ++n) f(row, u.pn * BM + bj * HALF + wc * 32 + n * 16 + 4 * fq, acc[ai][bj][m][n]); }
    }
};
template <class Epi, class Sched, bool ALIGN_EPI = false, bool SP2 = false>
__device__ __forceinline__ void gemm_phase(PG8_LAS unsigned char* lds, const Gemm g, const Sched& S, const Epi& E) {
    const int tid = threadIdx.x, wid = __builtin_amdgcn_readfirstlane(tid >> 6), lane = tid & 63, wr = wid >> 2, wc = wid & 3, fr = lane & 15, fq = lane >> 4;
    const int K = g.ld, KB = g.ldb ? g.ldb : g.ld, nt = g.K / BK;
    unsigned voffA, voffB;
    { int R, C; stage_rc(tid * 16, R, C); const int Rb = Epi::PERM ? ((R & ~31) + perm32(R & 31)) : R;
      voffA = (unsigned)(R * K + C) * 2u; voffB = (unsigned)(Rb * KB + C) * 2u; }
    const size_t rstep64A = (size_t)64 * K * 2, rstep64B = (size_t)64 * KB * 2;
    const size_t kstep = (size_t)(BK * 2);
    const size_t hstepA = (size_t)HALF * K * 2, hstepB = (size_t)HALF * KB * 2;
    const size_t tstepA = 2 * hstepA, tstepB = 2 * hstepB;
    const unsigned ldsw = (unsigned)wid * 1024u;
    const int aoff = lds_byte(wr * 64 + fr, fq * 8), boff = lds_byte(wc * 32 + fr, fq * 8);
#define PG8_SA(b, h) (((b) * 2 + (h)) * HTB)
#define PG8_SB(b, h) ((4 + (b) * 2 + (h)) * HTB)
#define PG8_STAGE(bufoff, gbase, voff, rstep64) do { _Pragma("unroll") for (int _i = 0; _i < 2; ++_i) \
        __builtin_amdgcn_global_load_lds((const unsigned*)((const char*)(gbase) + (size_t)_i * rstep64 + (voff)), (PG8_LAS unsigned*)(lds + (bufoff) + ldsw + _i * 8192), 16, 0, 0); } while (0)
#define PG8_LDA(dst, b, h) do { _Pragma("unroll") for (int m = 0; m < 4; ++m) _Pragma("unroll") for (int k = 0; k < 2; ++k) dst[m][k] = *(const PG8_LAS bf16x8*)(lds + PG8_SA(b, h) + aoff + m * 2048 + k * 1024); } while (0)
#define PG8_LDB(dst, b, h) do { _Pragma("unroll") for (int n = 0; n < 2; ++n) _Pragma("unroll") for (int k = 0; k < 2; ++k) dst[n][k] = *(const PG8_LAS bf16x8*)(lds + PG8_SB(b, h) + boff + n * 2048 + k * 1024); } while (0)
#define PG8_MMA(ai, bj, At, Bt) do { __builtin_amdgcn_s_setprio(1); _Pragma("unroll") for (int m = 0; m < 4; ++m) _Pragma("unroll") for (int n = 0; n < 2; ++n) _Pragma("unroll") for (int k = 0; k < 2; ++k) \
        acc[ai][bj][m][n] = __builtin_amdgcn_mfma_f32_16x16x32_bf16(Bt[n][k], At[m][k], acc[ai][bj][m][n], 0, 0, 0); __builtin_amdgcn_s_setprio(0); } while (0)
#define PG8_WAIT_V(n) asm volatile("s_waitcnt vmcnt(" #n ")" ::: "memory")
#define PG8_WAIT_L(n) asm volatile("s_waitcnt lgkmcnt(" #n ")" ::: "memory")
#define PG8_BAR __builtin_amdgcn_s_barrier()
#define PG8_SCHED __builtin_amdgcn_sched_barrier(0)
    Unit cur, nxt; int ui = 0;
    if (!S.next(0, cur)) return;
    f32x4 acc[2][2][4][2];
#pragma unroll
    for (int a = 0; a < 2; ++a)
#pragma unroll
        for (int b = 0; b < 2; ++b)
#pragma unroll
            for (int m = 0; m < 4; ++m)
#pragma unroll
                for (int n = 0; n < 2; ++n) acc[a][b][m][n] = (f32x4){0.f, 0.f, 0.f, 0.f};
    bf16x8 At[4][2], B0[2][2], B1[2][2];
    const char* cA = (const char*)g.A + (size_t)cur.pm * tstepA + (size_t)cur.k0 * 2; const char* cB = (const char*)g.Bt + (size_t)cur.pn * tstepB + (size_t)cur.k0 * 2;
    S.a_ready(cur);
    if constexpr (SP2) {
        PG8_STAGE(PG8_SB(0, 0), cB, voffB, rstep64B); PG8_STAGE(PG8_SB(0, 1), cB + hstepB, voffB, rstep64B); PG8_STAGE(PG8_SA(0, 0), cA, voffA, rstep64A); PG8_STAGE(PG8_SA(0, 1), cA + hstepA, voffA, rstep64A);
        if (wr == 1) PG8_BAR;
        PG8_WAIT_V(2); PG8_BAR;
        PG8_STAGE(PG8_SB(1, 0), cB + kstep, voffB, rstep64B); PG8_STAGE(PG8_SA(1, 0), cA + kstep, voffA, rstep64A); PG8_STAGE(PG8_SB(1, 1), cB + hstepB + kstep, voffB, rstep64B);
        PG8_WAIT_V(6); PG8_BAR;
    } else {
        PG8_STAGE(PG8_SB(0, 0), cB, voffB, rstep64B); PG8_STAGE(PG8_SA(0, 0), cA, voffA, rstep64A); PG8_STAGE(PG8_SB(0, 1), cB + hstepB, voffB, rstep64B); PG8_STAGE(PG8_SA(0, 1), cA + hstepA, voffA, rstep64A);
        if (wr == 1) PG8_BAR;
        PG8_WAIT_V(4); PG8_BAR;
        PG8_STAGE(PG8_SB(1, 0), cB + kstep, voffB, rstep64B); PG8_STAGE(PG8_SA(1, 0), cA + kstep, voffA, rstep64A); PG8_STAGE(PG8_SB(1, 1), cB + hstepB + kstep, voffB, rstep64B);
        PG8_WAIT_V(6); PG8_BAR;
    }
    for (;;) {
        const bool has_next = S.next(ui + 1, nxt);
        const char* nA = has_next ? (const char*)g.A + (size_t)nxt.pm * tstepA + (size_t)nxt.k0 * 2 : cA; const char* nB = has_next ? (const char*)g.Bt + (size_t)nxt.pn * tstepB + (size_t)nxt.k0 * 2 : cB;
        for (int t = 0; t < nt; t += 2) {
            const bool last = (t == nt - 2);
            const char* a1 = cA + (size_t)(t + 1) * kstep;
            const char* a2 = last ? nA : cA + (size_t)(t + 2) * kstep; const char* b2 = last ? nB : cB + (size_t)(t + 2) * kstep;
            const char* a3 = a2 + kstep; const char* b3 = b2 + kstep;
            if (last && has_next) S.a_ready(nxt);
            if constexpr (SP2) {
            PG8_LDB(B0, 0, 0); PG8_LDB(B1, 0, 1); PG8_SCHED; PG8_LDA(At, 0, 0); PG8_STAGE(PG8_SA(1, 1), a1 + hstepA, voffA, rstep64A);
            PG8_WAIT_V(8); PG8_WAIT_L(0); PG8_BAR; PG8_MMA(0, 0, At, B0); PG8_MMA(0, 1, At, B1); PG8_BAR; PG8_SCHED;
            PG8_LDA(At, 0, 1); PG8_STAGE(PG8_SB(0, 0), b2, voffB, rstep64B); PG8_STAGE(PG8_SB(0, 1), b2 + hstepB, voffB, rstep64B); PG8_STAGE(PG8_SA(0, 0), a2, voffA, rstep64A);
            PG8_WAIT_V(8); PG8_WAIT_L(0); PG8_BAR; PG8_MMA(1, 0, At, B0); PG8_MMA(1, 1, At, B1); PG8_BAR; PG8_SCHED;
            PG8_LDB(B0, 1, 0); PG8_LDB(B1, 1, 1); PG8_SCHED; PG8_LDA(At, 1, 0); PG8_STAGE(PG8_SA(0, 1), a2 + hstepA, voffA, rstep64A);
            PG8_WAIT_V(8); PG8_WAIT_L(0); PG8_BAR; PG8_MMA(0, 0, At, B0); PG8_MMA(0, 1, At, B1); PG8_BAR; PG8_SCHED;
            PG8_LDA(At, 1, 1); PG8_STAGE(PG8_SB(1, 0), b3, voffB, rstep64B); PG8_STAGE(PG8_SB(1, 1), b3 + hstepB, voffB, rstep64B); PG8_STAGE(PG8_SA(1, 0), a3, voffA, rstep64A);
            PG8_WAIT_V(8); PG8_WAIT_L(0); PG8_BAR; PG8_MMA(1, 0, At, B0); PG8_MMA(1, 1, At, B1); PG8_BAR; PG8_SCHED;
            } else {
            PG8_LDB(B0, 0, 0); PG8_SCHED; PG8_LDA(At, 0, 0); PG8_STAGE(PG8_SA(1, 1), a1 + hstepA, voffA, rstep64A);
            PG8_WAIT_L(8); PG8_BAR; PG8_WAIT_L(0); PG8_MMA(0, 0, At, B0); PG8_BAR; PG8_SCHED;
            PG8_LDB(B1, 0, 1); PG8_STAGE(PG8_SB(0, 0), b2, voffB, rstep64B);
            PG8_BAR; PG8_WAIT_L(0); PG8_MMA(0, 1, At, B1); PG8_BAR;
            PG8_LDA(At, 0, 1); PG8_STAGE(PG8_SA(0, 0), a2, voffA, rstep64A);
            PG8_BAR; PG8_WAIT_L(0); PG8_MMA(1, 0, At, B0); PG8_BAR; PG8_SCHED;
            PG8_STAGE(PG8_SB(0, 1), b2 + hstepB, voffB, rstep64B);
            PG8_WAIT_V(6); PG8_BAR; PG8_MMA(1, 1, At, B1); PG8_BAR;
            PG8_LDB(B0, 1, 0); PG8_SCHED; PG8_LDA(At, 1, 0); PG8_STAGE(PG8_SA(0, 1), a2 + hstepA, voffA, rstep64A);
            PG8_WAIT_L(8); PG8_BAR; PG8_WAIT_L(0); PG8_MMA(0, 0, At, B0); PG8_BAR; PG8_SCHED;
            PG8_LDB(B1, 1, 1); PG8_STAGE(PG8_SB(1, 0), b3, voffB, rstep64B);
            PG8_BAR; PG8_WAIT_L(0); PG8_MMA(0, 1, At, B1); PG8_BAR;
            PG8_LDA(At, 1, 1); PG8_STAGE(PG8_SA(1, 0), a3, voffA, rstep64A);
            PG8_BAR; PG8_WAIT_L(0); PG8_MMA(1, 0, At, B0); PG8_BAR; PG8_SCHED;
            PG8_STAGE(PG8_SB(1, 1), b3 + hstepB, voffB, rstep64B);
            PG8_WAIT_V(6); PG8_BAR; PG8_MMA(1, 1, At, B1); PG8_BAR;
            }
        }
        if constexpr (ALIGN_EPI) { if (wr == 0) PG8_BAR; }
        if constexpr (!Epi::AFTER_DRAIN) { E(acc, cur, wr, wc, fr, fq); S.done(cur); }
        if (!has_next) break;
#pragma unroll
        for (int a = 0; a < 2; ++a)
#pragma unroll
            for (int b = 0; b < 2; ++b)
#pragma unroll
                for (int m = 0; m < 4; ++m)
#pragma unroll
                    for (int n = 0; n < 2; ++n) acc[a][b][m][n] = (f32x4){0.f, 0.f, 0.f, 0.f};
        cur = nxt; cA = nA; cB = nB; ++ui;
        if constexpr (ALIGN_EPI) { if (wr == 1) PG8_BAR; }
    }
    PG8_WAIT_V(0);
    if constexpr (!ALIGN_EPI) { if (wr == 0) PG8_BAR; }
    PG8_BAR;
    if constexpr (Epi::AFTER_DRAIN) { E.fused(acc, cur, wr, wc, fr, fq, lds, wid, lane); S.done(cur); }
#undef PG8_SA
#undef PG8_SB
#undef PG8_STAGE
#undef PG8_LDA
#undef PG8_LDB
#undef PG8_MMA
#undef PG8_WAIT_V
#undef PG8_WAIT_L
#undef PG8_BAR
#undef PG8_SCHED
}
}

#define LAS __attribute__((address_space(3)))
typedef unsigned short bf16_t;
typedef short bf16x8 __attribute__((ext_vector_type(8)));
typedef short s16x4 __attribute__((ext_vector_type(4)));
typedef float f32x4 __attribute__((ext_vector_type(4)));
typedef float f32x2 __attribute__((ext_vector_type(2)));
typedef unsigned u32x4 __attribute__((ext_vector_type(4)));
typedef unsigned u32x2 __attribute__((ext_vector_type(2)));

constexpr int MP = 16384, MS = 512, MT = MP + MS;
constexpr int NZ = 4864;
constexpr int ZK = 512, ZV = 640, ZDQ = 768, ZDZ = 2304, ZGA = 2816, ZGB = 3840;
constexpr int NTHR = 512;
constexpr int LDS_BYTES = 163840;
constexpr float EPS = 1e-6f;

constexpr size_t O_Y = 0;
constexpr size_t O_PWK = (size_t)MT * 1024;
constexpr size_t O_PWV = O_PWK + 131072;
constexpr size_t O_PDC = O_PWV + 131072;
constexpr size_t O_PDS = O_PDC + 36864;
constexpr size_t O_PMK = O_PDS + 524288;
constexpr size_t O_PMV = O_PMK + 1048576;
constexpr size_t O_PFC = O_PMV + 1048576;
constexpr size_t O_SWK = O_PFC + 45056;
constexpr size_t O_SWV = O_SWK + 2097152;
constexpr size_t O_SDC = O_SWV + 2097152;
constexpr size_t O_SDS = O_SDC + 589824;
constexpr size_t O_SFC = O_SDS + 8388608;
constexpr size_t O_END = O_SFC + 720896;

constexpr size_t WS_WIN = 0;
constexpr size_t WS_WA = WS_WIN + (size_t)4864 * 1024 * 2;
constexpr size_t WS_WB = WS_WA + (size_t)1024 * 512 * 2;
constexpr size_t WS_WMO = WS_WB + (size_t)1024 * 512 * 2;
constexpr size_t WS_WXQ = WS_WMO + (size_t)1024 * 1024 * 2;
constexpr size_t WS_WXKV = WS_WXQ + (size_t)512 * 1024 * 2;
constexpr size_t WS_WXO = WS_WXKV + (size_t)1024 * 1024 * 2;
constexpr size_t WS_WUP = WS_WXO + (size_t)1024 * 512 * 2;
constexpr size_t WS_WDN = WS_WUP + (size_t)5632 * 1024 * 2;
constexpr size_t WS_RA = WS_WDN + (size_t)1024 * 2816 * 2;
constexpr size_t WS_Z = WS_RA + (size_t)MT * 1024 * 2;
constexpr size_t WS_YA = WS_Z + (size_t)MT * NZ * 2;
constexpr size_t WS_YB = WS_YA + (size_t)MT * 512 * 2;
constexpr size_t WS_MEMN = WS_YB + (size_t)MT * 512 * 2;
constexpr size_t WS_GB = WS_MEMN + (size_t)2048 * 1024 * 2;
constexpr size_t WS_ROPE = WS_GB + (size_t)MT * 8 * 4;
constexpr size_t WS_GLAST = WS_ROPE + (size_t)2052 * 16 * 4;
constexpr size_t WS_CTL = WS_GLAST + 4096;
constexpr size_t WS_END = WS_CTL + 16384;
constexpr size_t ZO_HQ = 0, ZO_XO = (size_t)MT * 512 * 2;
constexpr size_t ZO_UG = 0;
static_assert(ZO_UG + (size_t)MT * 5632 * 2 <= (size_t)MT * NZ * 2 + 2 * (size_t)MT * 512 * 2 && WS_YA == WS_Z + (size_t)MT * NZ * 2 && WS_YB == WS_YA + (size_t)MT * 512 * 2, "FFN overlay fits in Z|YA|YB");

struct Params { const float* in[30]; float* out; unsigned char* ws; double inv[8]; };

__device__ __forceinline__ unsigned f2bf(float f) { unsigned r; asm("v_cvt_pk_bf16_f32 %0, %1, %1" : "=v"(r) : "v"(f)); return r & 0xffffu; }
__device__ __forceinline__ unsigned pk2(float lo, float hi) { unsigned r; asm("v_cvt_pk_bf16_f32 %0, %1, %2" : "=v"(r) : "v"(lo), "v"(hi)); return r; }
__device__ __forceinline__ float bf2f(unsigned short b) { return __builtin_bit_cast(float, (unsigned)b << 16); }
__device__ __forceinline__ float bflo(unsigned w) { return __builtin_bit_cast(float, w << 16); }
__device__ __forceinline__ float bfhi(unsigned w) { return __builtin_bit_cast(float, w & 0xffff0000u); }
__device__ __forceinline__ float sigm(float x) { return __builtin_amdgcn_rcpf(1.f + __expf(-x)); }
__device__ __forceinline__ float silu(float x) { return x * __builtin_amdgcn_rcpf(1.f + __expf(-x)); }
__device__ __forceinline__ float wave_sum(float v) {
#pragma unroll
    for (int o = 1; o < 64; o <<= 1) v += __shfl_xor(v, o);
    return v;
}

#define LBAR() do { asm volatile("s_waitcnt lgkmcnt(0)" ::: "memory"); __builtin_amdgcn_s_barrier(); asm volatile("" ::: "memory"); } while (0)
struct FMem { float* pk; float* pv;
    __device__ __forceinline__ void operator()(int row, int col, const f32x4& v) const {
        float* d = (col < 512) ? (pk + (size_t)row * 512 + col) : (pv + (size_t)row * 512 + (col - 512)); *(f32x4*)d = v; } };
struct FGateA { const bf16_t* Z; float* t1;
    __device__ __forceinline__ void operator()(int row, int col, const f32x4& v) const {
        const u32x2 g = *(const u32x2*)(Z + (size_t)row * NZ + ZGA + col);
        f32x4 o; o[0] = sigm(bflo(g.x)) * v[0]; o[1] = sigm(bfhi(g.x)) * v[1]; o[2] = sigm(bflo(g.y)) * v[2]; o[3] = sigm(bfhi(g.y)) * v[3];
        *(f32x4*)(t1 + (size_t)row * 1024 + col) = o; } };
struct FGateB { const bf16_t* Z; const float* t1; bf16_t* mix;
    __device__ __forceinline__ void operator()(int row, int col, const f32x4& v) const {
        const u32x2 g = *(const u32x2*)(Z + (size_t)row * NZ + ZGB + col);
        const f32x4 t = *(const f32x4*)(t1 + (size_t)row * 1024 + col);
        u32x2 w; w.x = pk2(t[0] + sigm(bflo(g.x)) * v[0], t[1] + sigm(bfhi(g.x)) * v[1]); w.y = pk2(t[2] + sigm(bflo(g.y)) * v[2], t[3] + sigm(bfhi(g.y)) * v[3]);
        *(u32x2*)(mix + (size_t)row * 1024 + col) = w; } };
struct FResX { const float* xp; const float* xs; float* h;
    __device__ __forceinline__ void operator()(int row, int col, const f32x4& v) const {
        const float* x = (row < MP) ? (xp + (size_t)row * 1024 + col) : (xs + (size_t)(row - MP) * 1024 + col);
        *(f32x4*)(h + (size_t)row * 1024 + col) = *(const f32x4*)x + v; } };
struct FAcc { float* h; int row_off;
    __device__ __forceinline__ void operator()(int row, int col, const f32x4& v) const {
        float* d = h + (size_t)(row + row_off) * 1024 + col; *(f32x4*)d = *(const f32x4*)d + v; } };

struct FGateA8 { const bf16_t* Z; bf16_t* t1;
    struct L { u32x4 g; };
    __device__ __forceinline__ L load(int row, int col) const { L l; l.g = *(const u32x4*)(Z + (size_t)row * NZ + ZGA + col); return l; }
    __device__ __forceinline__ void apply(int row, int col, const f32x4& v0, const f32x4& v1, const L& l) const {
        const u32x4 g = l.g;
        u32x4 w; w.x = pk2(sigm(bflo(g.x)) * v0[0], sigm(bfhi(g.x)) * v0[1]); w.y = pk2(sigm(bflo(g.y)) * v0[2], sigm(bfhi(g.y)) * v0[3]);
        w.z = pk2(sigm(bflo(g.z)) * v1[0], sigm(bfhi(g.z)) * v1[1]); w.w = pk2(sigm(bflo(g.w)) * v1[2], sigm(bfhi(g.w)) * v1[3]);
        *(u32x4*)(t1 + (size_t)row * 1024 + col) = w; } };
struct FGateB8 { const bf16_t* Z; const bf16_t* t1; bf16_t* mix;
    struct L { u32x4 g, t; };
    __device__ __forceinline__ L load(int row, int col) const { L l; l.g = *(const u32x4*)(Z + (size_t)row * NZ + ZGB + col); l.t = *(const u32x4*)(t1 + (size_t)row * 1024 + col); return l; }
    __device__ __forceinline__ void apply(int row, int col, const f32x4& v0, const f32x4& v1, const L& l) const {
        const u32x4 g = l.g, tw = l.t;
        u32x4 w; w.x = pk2(bflo(tw.x) + sigm(bflo(g.x)) * v0[0], bfhi(tw.x) + sigm(bfhi(g.x)) * v0[1]); w.y = pk2(bflo(tw.y) + sigm(bflo(g.y)) * v0[2], bfhi(tw.y) + sigm(bfhi(g.y)) * v0[3]);
        w.z = pk2(bflo(tw.z) + sigm(bflo(g.z)) * v1[0], bfhi(tw.z) + sigm(bfhi(g.z)) * v1[1]); w.w = pk2(bflo(tw.w) + sigm(bflo(g.w)) * v1[2], bfhi(tw.w) + sigm(bfhi(g.w)) * v1[3]);
        *(u32x4*)(mix + (size_t)row * 1024 + col) = w; } };
struct FResX8 { const float* xp; float* h;
    struct L { f32x4 a, b; };
    __device__ __forceinline__ L load(int row, int col) const { const float* x = xp + (size_t)row * 1024 + col; L l; l.a = *(const f32x4*)x; l.b = *(const f32x4*)(x + 4); return l; }
    __device__ __forceinline__ void apply(int row, int col, const f32x4& v0, const f32x4& v1, const L& l) const {
        float* d = h + (size_t)row * 1024 + col; *(f32x4*)d = l.a + v0; *(f32x4*)(d + 4) = l.b + v1; } };
struct FAcc8 { float* h;
    struct L { f32x4 a, b; };
    __device__ __forceinline__ L load(int row, int col) const { const float* x = h + (size_t)row * 1024 + col; L l; l.a = *(const f32x4*)x; l.b = *(const f32x4*)(x + 4); return l; }
    __device__ __forceinline__ void apply(int row, int col, const f32x4& v0, const f32x4& v1, const L& l) const {
        float* d = h + (size_t)row * 1024 + col; *(f32x4*)d = l.a + v0; *(f32x4*)(d + 4) = l.b + v1; } };
struct FAccAtomic { float* h;
    __device__ __forceinline__ void operator()(int row, int col, const f32x4& v) const {
        float* d = h + (size_t)row * 1024 + col;
#pragma unroll
        for (int e = 0; e < 4; ++e) (void)__hip_atomic_fetch_add(d + e, v[e], __ATOMIC_RELAXED, __HIP_MEMORY_SCOPE_AGENT); } };

__device__ __forceinline__ void transpose_item(const float* __restrict__ W, int ldw, int col0, int K, int ncols, bf16_t* WT, int row_off, LAS float* scr, int item, int lane) {
    const int nblk = ncols / 32, kb = item / nblk, nb = item % nblk, k0 = 64 * kb, n0 = 32 * nb;
#pragma unroll
    for (int i = 0; i < 32; ++i) { const int kk = 2 * i + (lane >> 5); scr[kk * 33 + (lane & 31)] = W[(size_t)(k0 + kk) * ldw + col0 + n0 + (lane & 31)]; }
    asm volatile("s_waitcnt lgkmcnt(0)" ::: "memory");
    const int c = lane & 7;
#pragma unroll
    for (int j = 0; j < 4; ++j) { const int n = (lane >> 3) + 8 * j; const LAS float* s = scr + (8 * c) * 33 + n;
        u32x4 o; o.x = pk2(s[0 * 33], s[1 * 33]); o.y = pk2(s[2 * 33], s[3 * 33]); o.z = pk2(s[4 * 33], s[5 * 33]); o.w = pk2(s[6 * 33], s[7 * 33]);
        *(u32x4*)(WT + (size_t)(row_off + n0 + n) * K + k0 + 8 * c) = o; }
    asm volatile("s_waitcnt lgkmcnt(0)" ::: "memory");
}

template <bool DAB>
__device__ __forceinline__ void norm_row_bf16(const float* xrow, const float* g, bf16_t* orow, int lane, const LAS float* sW, float* gb_out, const float* alog, const float* dtb) {
    f32x4 v[4]; float ss = 0.f;
#pragma unroll
    for (int j = 0; j < 4; ++j) { v[j] = ((const f32x4*)xrow)[lane + 64 * j]; ss += (v[j][0] * v[j][0] + v[j][1] * v[j][1]) + (v[j][2] * v[j][2] + v[j][3] * v[j][3]); }
    const float rs = __builtin_amdgcn_rsqf(wave_sum(ss) * (1.f / 1024.f) + EPS);
#pragma unroll
    for (int j = 0; j < 4; ++j) { const f32x4 gg = ((const f32x4*)g)[lane + 64 * j]; v[j] = v[j] * rs * gg;
        u32x2 w; w.x = pk2(v[j][0], v[j][1]); w.y = pk2(v[j][2], v[j][3]); ((u32x2*)orow)[lane + 64 * j] = w; }
    if constexpr (DAB) {
        float acc[8];
#pragma unroll
        for (int i = 0; i < 8; ++i) acc[i] = 0.f;
#pragma unroll
        for (int j = 0; j < 4; ++j)
#pragma unroll
            for (int e = 0; e < 4; ++e) { const int k = 4 * lane + 256 * j + e; const f32x4 w0 = *(const LAS f32x4*)(sW + k * 8), w1 = *(const LAS f32x4*)(sW + k * 8 + 4); const float x = v[j][e];
                acc[0] += x * w0[0]; acc[1] += x * w0[1]; acc[2] += x * w0[2]; acc[3] += x * w0[3]; acc[4] += x * w1[0]; acc[5] += x * w1[1]; acc[6] += x * w1[2]; acc[7] += x * w1[3]; }
#pragma unroll
        for (int i = 0; i < 8; ++i) acc[i] = wave_sum(acc[i]);
        if (lane == 0) {
            f32x4 o0, o1;
#pragma unroll
            for (int i = 0; i < 4; ++i) { const float x = acc[i] + dtb[i]; const float sp = (x > 20.f) ? x : log1pf(expf(x)); o0[i] = -expf(alog[i]) * sp; o1[i] = 1.f / (1.f + expf(-acc[4 + i])); }
            *(f32x4*)gb_out = o0; *(f32x4*)(gb_out + 4) = o1;
        }
    }
}

__device__ __forceinline__ void p0_prologue(const Params& p, LAS unsigned char* lds, int tid, int lane, int wave, int G) {
    unsigned char* ws = p.ws;
    LAS float* scr = (LAS float*)(lds + wave * 16384);
    const int gw = blockIdx.x * 8 + wave, NGW = G * 8;
    constexpr int I1 = 16 * 88, I2 = 16 * 64, I3 = 8 * 32, I5 = 16 * 32, I6 = 16 * 16, I9 = 16 * 176, I10 = 44 * 32;
    constexpr int NITEMS = I1 + I2 + I3 + I3;
    for (int it = gw; it < NITEMS; it += NGW) {
        int r = it;
        if (r < I1) { transpose_item(p.in[11], 4872, 0, 1024, 2816, (bf16_t*)(ws + WS_WIN), 0, scr, r, lane); continue; } r -= I1;
        if (r < I2) { transpose_item(p.in[11], 4872, 2824, 1024, 2048, (bf16_t*)(ws + WS_WIN), 2816, scr, r, lane); continue; } r -= I2;
        if (r < I3) { transpose_item(p.in[17], 1024, 0, 512, 1024, (bf16_t*)(ws + WS_WA), 0, scr, r, lane); continue; } r -= I3;
        transpose_item(p.in[18], 1024, 0, 512, 1024, (bf16_t*)(ws + WS_WB), 0, scr, r, lane);
    }
    (void)I5; (void)I6;
    {
        float* tab = (float*)(ws + WS_ROPE);
        for (int idx = blockIdx.x * NTHR + tid; idx < 2052 * 8; idx += G * NTHR) {
            const int pi = idx >> 3, i = idx & 7; const int pos = pi < 2048 ? pi : 16384 + (pi - 2048);
            double t = (double)pos * p.inv[i] * 0.15915494309189535; t -= __builtin_floor(t);
            const float r = (float)t;
            tab[idx * 2] = __builtin_amdgcn_cosf(r); tab[idx * 2 + 1] = __builtin_amdgcn_sinf(r);
        }
    }
    __syncthreads();
    LAS float* sW = (LAS float*)lds;
    for (int e = tid; e < 8192; e += NTHR) sW[e] = p.in[11][(size_t)(e >> 3) * 4872 + 2816 + (e & 7)];
    __syncthreads();
    for (int m = gw; m < MT; m += 2 * NGW) {
        const int mb = (m + NGW < MT) ? (m + NGW) : m;
        const float* xa = (m < MP) ? p.in[0] + (size_t)m * 1024 : p.in[1] + (size_t)(m - MP) * 1024;
        const float* xb = (mb < MP) ? p.in[0] + (size_t)mb * 1024 : p.in[1] + (size_t)(mb - MP) * 1024;
        f32x4 va[4], vb[4]; float sa = 0.f, sb = 0.f;
#pragma unroll
        for (int j = 0; j < 4; ++j) { va[j] = ((const f32x4*)xa)[lane + 64 * j]; vb[j] = ((const f32x4*)xb)[lane + 64 * j]; }
#pragma unroll
        for (int j = 0; j < 4; ++j) { sa += (va[j][0] * va[j][0] + va[j][1] * va[j][1]) + (va[j][2] * va[j][2] + va[j][3] * va[j][3]); sb += (vb[j][0] * vb[j][0] + vb[j][1] * vb[j][1]) + (vb[j][2] * vb[j][2] + vb[j][3] * vb[j][3]); }
#pragma unroll
        for (int o = 1; o < 64; o <<= 1) { sa += __shfl_xor(sa, o); sb += __shfl_xor(sb, o); }
        const float ra = __builtin_amdgcn_rsqf(sa * (1.f / 1024.f) + EPS), rb = __builtin_amdgcn_rsqf(sb * (1.f / 1024.f) + EPS);
        float acc[16];
#pragma unroll
        for (int i = 0; i < 16; ++i) acc[i] = 0.f;
        bf16_t* oa = (bf16_t*)(ws + WS_RA) + (size_t)m * 1024; bf16_t* ob = (bf16_t*)(ws + WS_RA) + (size_t)mb * 1024;
#pragma unroll
        for (int j = 0; j < 4; ++j) { const f32x4 gg = ((const f32x4*)p.in[10])[lane + 64 * j]; va[j] = va[j] * ra * gg; vb[j] = vb[j] * rb * gg;
            u32x2 w; w.x = pk2(va[j][0], va[j][1]); w.y = pk2(va[j][2], va[j][3]); ((u32x2*)oa)[lane + 64 * j] = w;
            u32x2 w2; w2.x = pk2(vb[j][0], vb[j][1]); w2.y = pk2(vb[j][2], vb[j][3]); ((u32x2*)ob)[lane + 64 * j] = w2;
#pragma unroll
            for (int e = 0; e < 4; ++e) { const int k = 4 * lane + 256 * j + e; const f32x4 w0 = *(const LAS f32x4*)(sW + k * 8), w1 = *(const LAS f32x4*)(sW + k * 8 + 4); const float xA = va[j][e], xB = vb[j][e];
                acc[0] += xA * w0[0]; acc[1] += xA * w0[1]; acc[2] += xA * w0[2]; acc[3] += xA * w0[3]; acc[4] += xA * w1[0]; acc[5] += xA * w1[1]; acc[6] += xA * w1[2]; acc[7] += xA * w1[3];
                acc[8] += xB * w0[0]; acc[9] += xB * w0[1]; acc[10] += xB * w0[2]; acc[11] += xB * w0[3]; acc[12] += xB * w1[0]; acc[13] += xB * w1[1]; acc[14] += xB * w1[2]; acc[15] += xB * w1[3]; } }
#pragma unroll
        for (int o = 1; o < 64; o <<= 1) {
#pragma unroll
            for (int i = 0; i < 16; ++i) acc[i] += __shfl_xor(acc[i], o); }
        if (lane < 2) { const int r = lane ? mb : m; const float* a8 = acc;
            f32x4 o0, o1;
#pragma unroll
            for (int i = 0; i < 4; ++i) { const float da = lane ? a8[8 + i] : a8[i], db = lane ? a8[12 + i] : a8[4 + i];
                const float x = da + p.in[14][i]; const float sp = (x > 20.f) ? x : log1pf(expf(x)); o0[i] = -expf(p.in[13][i]) * sp; o1[i] = 1.f / (1.f + expf(-db)); }
            float* gbo = (float*)(ws + WS_GB) + (size_t)r * 8; *(f32x4*)gbo = o0; *(f32x4*)(gbo + 4) = o1; }
    }
    for (int m = gw; m < 2048; m += NGW)
        norm_row_bf16<false>(p.in[2] + (size_t)m * 1024, p.in[21], (bf16_t*)(ws + WS_MEMN) + (size_t)m * 1024, lane, sW, nullptr, nullptr, nullptr);
}

#define MFMA16(a, b, c) __builtin_amdgcn_mfma_f32_16x16x32_bf16(a, b, c, 0, 0, 0)
__device__ __forceinline__ bf16x8 pack_p(const f32x4& a, const f32x4& b) {
    u32x4 w; w.x = pk2(a[0], a[1]); w.y = pk2(a[2], a[3]); w.z = pk2(b[0], b[1]); w.w = pk2(b[2], b[3]); return __builtin_bit_cast(bf16x8, w);
}

__device__ __forceinline__ void swa_prompt_item(const Params& p, LAS unsigned char* lds, int item, int tid, int lane, int wave) {
    const int kvh = item & 1, blk = (item >> 1) & 15, b = item >> 5;
    const bf16_t* Z = (const bf16_t*)(p.ws + WS_Z);
    const float* tab = (const float*)(p.ws + WS_ROPE);
    LAS bf16_t* sK = (LAS bf16_t*)lds;
    LAS bf16_t* sVt = (LAS bf16_t*)(lds + 36864);
    {
        const int key = tid >> 1, half = tid & 1;
        const int pos = blk * 128 - 128 + key;
        u32x4 k4[4], v4[4];
        if (pos >= 0) { const bf16_t* zr = Z + (size_t)(b * 2048 + pos) * NZ;
#pragma unroll
            for (int i = 0; i < 4; ++i) { k4[i] = *(const u32x4*)(zr + ZK + kvh * 64 + 32 * half + 8 * i); v4[i] = *(const u32x4*)(zr + ZV + kvh * 64 + 32 * half + 8 * i); }
            if (half == 0) {
                const f32x4* cs = (const f32x4*)(tab + (size_t)pos * 16);
                u32x4 r1, r2;
#pragma unroll
                for (int w = 0; w < 4; ++w) { const f32x4 c4 = cs[w];
                    const float a0 = bflo(k4[0][w]), a1 = bfhi(k4[0][w]), b0 = bflo(k4[1][w]), b1 = bfhi(k4[1][w]);
                    r1[w] = pk2(a0 * c4[0] - b0 * c4[1], a1 * c4[2] - b1 * c4[3]);
                    r2[w] = pk2(b0 * c4[0] + a0 * c4[1], b1 * c4[2] + a1 * c4[3]); }
                k4[0] = r1; k4[1] = r2;
            }
        } else {
#pragma unroll
            for (int i = 0; i < 4; ++i) { k4[i] = (u32x4){0u, 0u, 0u, 0u}; v4[i] = (u32x4){0u, 0u, 0u, 0u}; }
        }
#pragma unroll
        for (int i = 0; i < 4; ++i) *(LAS u32x4*)(sK + key * 72 + 32 * half + 8 * i) = k4[i];
#pragma unroll
        for (int i = 0; i < 4; ++i)
#pragma unroll
            for (int w = 0; w < 4; ++w) { sVt[(32 * half + 8 * i + 2 * w) * 264 + key] = (bf16_t)(v4[i][w] & 0xffffu); sVt[(32 * half + 8 * i + 2 * w + 1) * 264 + key] = (bf16_t)(v4[i][w] >> 16); }
        if (blk == 15 && key >= 128) {
            float* ok = p.out + O_PWK + ((size_t)(b * 128 + key - 128) * 2 + kvh) * 64 + 32 * half;
            float* ov = p.out + O_PWV + ((size_t)(b * 128 + key - 128) * 2 + kvh) * 64 + 32 * half;
#pragma unroll
            for (int i = 0; i < 4; ++i) {
                *(f32x4*)(ok + 8 * i) = (f32x4){bflo(k4[i][0]), bfhi(k4[i][0]), bflo(k4[i][1]), bfhi(k4[i][1])};
                *(f32x4*)(ok + 8 * i + 4) = (f32x4){bflo(k4[i][2]), bfhi(k4[i][2]), bflo(k4[i][3]), bfhi(k4[i][3])};
                *(f32x4*)(ov + 8 * i) = (f32x4){bflo(v4[i][0]), bfhi(v4[i][0]), bflo(v4[i][1]), bfhi(v4[i][1])};
                *(f32x4*)(ov + 8 * i + 4) = (f32x4){bflo(v4[i][2]), bfhi(v4[i][2]), bflo(v4[i][3]), bfhi(v4[i][3])};
            }
        }
    }
    LBAR();
    {
        const int g = wave >> 1, hq = kvh * 4 + g;
        const int l15 = lane & 15, q4 = lane >> 4;
        const float sink = p.in[16][hq];
        bf16_t* ya = (bf16_t*)(p.ws + WS_YA);
#pragma unroll 1
        for (int qp = 0; qp < 2; ++qp) {
        const int qbase = 64 * (wave & 1) + 32 * qp;
        bf16x8 qf[2][2];
#pragma unroll
        for (int qb = 0; qb < 2; ++qb) {
            const int qpos = blk * 128 + qbase + 16 * qb + l15;
            const bf16_t* zr = Z + (size_t)(b * 2048 + qpos) * NZ + hq * 64;
            qf[qb][0] = *(const bf16x8*)(zr + 8 * q4); qf[qb][1] = *(const bf16x8*)(zr + 32 + 8 * q4);
            const u32x4 own = __builtin_bit_cast(u32x4, qf[qb][0]); u32x4 oth;
#pragma unroll
            for (int w = 0; w < 4; ++w) oth[w] = (unsigned)__shfl_xor((int)own[w], 16);
            if (q4 < 2) {
                const f32x4* cs = (const f32x4*)(tab + (size_t)qpos * 16);
                const float sg = (q4 == 0) ? -1.f : 1.f; u32x4 r;
#pragma unroll
                for (int w = 0; w < 4; ++w) { const f32x4 c4 = cs[w];
                    r[w] = pk2(bflo(own[w]) * c4[0] + sg * bflo(oth[w]) * c4[1], bfhi(own[w]) * c4[2] + sg * bfhi(oth[w]) * c4[3]); }
                qf[qb][0] = __builtin_bit_cast(bf16x8, r);
            }
        }
        f32x4 o[4][2]; float mrow[2], lrow[2];
#pragma unroll
        for (int qb = 0; qb < 2; ++qb) { mrow[qb] = sink; lrow[qb] = (q4 == 0) ? 1.f : 0.f;
#pragma unroll
            for (int db = 0; db < 4; ++db) o[db][qb] = (f32x4){0.f, 0.f, 0.f, 0.f}; }
        int kt_lo = (wave & 1) ? 1 : 0; const int kt_hi = kt_lo + 3; if (blk == 0) kt_lo = 2;
        for (int kt = kt_lo; kt < kt_hi; ++kt) {
            f32x4 s[4][2];
#pragma unroll
            for (int kb = 0; kb < 4; ++kb) {
                const LAS bf16_t* kr = sK + (64 * kt + 16 * kb + l15) * 72 + 8 * q4;
                const bf16x8 kf0 = *(const LAS bf16x8*)kr, kf1 = *(const LAS bf16x8*)(kr + 32);
#pragma unroll
                for (int qb = 0; qb < 2; ++qb) { f32x4 z = (f32x4){0.f, 0.f, 0.f, 0.f}; z = MFMA16(kf0, qf[qb][0], z); s[kb][qb] = MFMA16(kf1, qf[qb][1], z); }
            }
#pragma unroll
            for (int qb = 0; qb < 2; ++qb) {
                const int i = qbase + 16 * qb + l15;
                float mx = -1e30f;
#pragma unroll
                for (int kb = 0; kb < 4; ++kb)
#pragma unroll
                    for (int r = 0; r < 4; ++r) { const int j = 64 * kt + 16 * kb + 4 * q4 + r; const bool ok = (unsigned)(j - i - 1) < 128u;
                        const float v = ok ? s[kb][qb][r] * 0.125f : -1e30f; s[kb][qb][r] = v; mx = fmaxf(mx, v); }
                mx = fmaxf(mx, __shfl_xor(mx, 16)); mx = fmaxf(mx, __shfl_xor(mx, 32));
                const float mn = fmaxf(mrow[qb], mx), alpha = __expf(mrow[qb] - mn); mrow[qb] = mn;
                float ls = lrow[qb] * alpha;
#pragma unroll
                for (int db = 0; db < 4; ++db) o[db][qb] = o[db][qb] * alpha;
#pragma unroll
                for (int kb = 0; kb < 4; ++kb)
#pragma unroll
                    for (int r = 0; r < 4; ++r) { const float pv = __expf(s[kb][qb][r] - mn); ls += pv; s[kb][qb][r] = pv; }
                lrow[qb] = ls;
            }
#pragma unroll
            for (int s2 = 0; s2 < 2; ++s2) {
                bf16x8 pb[2];
#pragma unroll
                for (int qb = 0; qb < 2; ++qb) pb[qb] = pack_p(s[2 * s2][qb], s[2 * s2 + 1][qb]);
#pragma unroll
                for (int db = 0; db < 4; ++db) {
                    const LAS bf16_t* vr = sVt + (16 * db + l15) * 264 + 64 * kt + 32 * s2 + 4 * q4;
                    const s16x4 lo = *(const LAS s16x4*)vr, hi = *(const LAS s16x4*)(vr + 16);
                    const bf16x8 vf = __builtin_shufflevector(lo, hi, 0, 1, 2, 3, 4, 5, 6, 7);
#pragma unroll
                    for (int qb = 0; qb < 2; ++qb) o[db][qb] = MFMA16(vf, pb[qb], o[db][qb]);
                }
            }
        }
#pragma unroll
        for (int qb = 0; qb < 2; ++qb) {
            float lt = lrow[qb]; lt += __shfl_xor(lt, 16); lt += __shfl_xor(lt, 32); const float inv = __builtin_amdgcn_rcpf(lt);
            const int row = b * 2048 + blk * 128 + qbase + 16 * qb + l15;
#pragma unroll
            for (int db = 0; db < 4; ++db) { u32x2 w; w.x = pk2(o[db][qb][0] * inv, o[db][qb][1] * inv); w.y = pk2(o[db][qb][2] * inv, o[db][qb][3] * inv);
                *(u32x2*)(ya + (size_t)row * 512 + hq * 64 + 16 * db + 4 * q4) = w; }
        }
        }
    }
    LBAR();
}

__device__ __forceinline__ void swa_sample_item(const Params& p, LAS unsigned char* lds, int item, int tid) {
    const int kv = item & 1, b = item >> 1;
    const bf16_t* Z = (const bf16_t*)(p.ws + WS_Z);
    const float* tab = (const float*)(p.ws + WS_ROPE);
    LAS float* sK = (LAS float*)lds;
    LAS float* sV = sK + 132 * 65;
    LAS float* sQ = sV + 132 * 64;
    LAS float* sP = sQ + 16 * 64;
    const float* cwk = p.in[3]; const float* cwv = p.in[4];
#pragma unroll 4
    for (int n = 0; n < 16; ++n) { const int e = tid + 512 * n, j = e >> 6, d = e & 63; const size_t a = ((size_t)(b * 128 + j) * 2 + kv) * 64 + d;
        sK[j * 65 + d] = cwk[a]; sV[j * 64 + d] = cwv[a]; }
    if (tid < 256) { const int t = tid >> 6, d = tid & 63; const bf16_t* zr = Z + (size_t)(MP + 4 * b + t) * NZ;
        sK[(128 + t) * 65 + d] = bf2f(zr[ZK + kv * 64 + d]); sV[(128 + t) * 64 + d] = bf2f(zr[ZV + kv * 64 + d]); }
#pragma unroll
    for (int n = 0; n < 2; ++n) { const int e = tid + 512 * n, qi = e >> 6, d = e & 63, t = qi >> 2, g = qi & 3;
        sQ[qi * 64 + d] = bf2f(Z[(size_t)(MP + 4 * b + t) * NZ + (kv * 4 + g) * 64 + d]); }
    LBAR();
    if (tid < 32) { const int t = tid >> 3, i = tid & 7; const float c = tab[((2048 + t) * 8 + i) * 2], s = tab[((2048 + t) * 8 + i) * 2 + 1];
        LAS float* x = sK + (128 + t) * 65; const float x1 = x[i], x2 = x[i + 8]; x[i] = x1 * c - x2 * s; x[i + 8] = x2 * c + x1 * s; }
    else if (tid >= 64 && tid < 192) { const int idx = tid - 64, qi = idx >> 3, i = idx & 7, t = qi >> 2; const float c = tab[((2048 + t) * 8 + i) * 2], s = tab[((2048 + t) * 8 + i) * 2 + 1];
        LAS float* x = sQ + qi * 64; const float x1 = x[i], x2 = x[i + 8]; x[i] = x1 * c - x2 * s; x[i + 8] = x2 * c + x1 * s; }
    LBAR();
#pragma unroll 4
    for (int n = 0; n < 16; ++n) { const int e = tid + 512 * n, jj = e >> 6, d = e & 63; const size_t a = ((size_t)(b * 128 + jj) * 2 + kv) * 64 + d;
        p.out[O_SWK + a] = sK[(jj + 4) * 65 + d]; p.out[O_SWV + a] = sV[(jj + 4) * 64 + d]; }
    const int qi = tid >> 5, jl = tid & 31, t = qi >> 2, g = qi & 3;
    const float sink = p.in[16][kv * 4 + g];
    float sc[5]; float mx = sink;
#pragma unroll
    for (int n = 0; n < 5; ++n) { const int j = jl + 32 * n; float v = -1e30f;
        if (j < 132 && j >= t + 1 && j <= t + 128) { float dot = 0.f;
#pragma unroll 16
            for (int d = 0; d < 64; ++d) dot += sQ[qi * 64 + d] * sK[j * 65 + d];
            v = dot * 0.125f; }
        sc[n] = v; mx = fmaxf(mx, v); }
#pragma unroll
    for (int o = 1; o < 32; o <<= 1) mx = fmaxf(mx, __shfl_xor(mx, o));
    float sum = 0.f;
#pragma unroll
    for (int n = 0; n < 5; ++n) { const float pv = __expf(sc[n] - mx); sum += pv; sc[n] = pv; }
#pragma unroll
    for (int o = 1; o < 32; o <<= 1) sum += __shfl_xor(sum, o);
    sum += __expf(sink - mx);
    const float inv = 1.f / sum;
#pragma unroll
    for (int n = 0; n < 5; ++n) { const int j = jl + 32 * n; if (j < 132) sP[qi * 132 + j] = sc[n] * inv; }
    LBAR();
    {
        const int d0 = jl * 2; float a0 = 0.f, a1 = 0.f;
        for (int j = 0; j < 132; ++j) { const float pj = sP[qi * 132 + j]; a0 += pj * sV[j * 64 + d0]; a1 += pj * sV[j * 64 + d0 + 1]; }
        bf16_t* ya = (bf16_t*)(p.ws + WS_YA);
        *(unsigned*)(ya + (size_t)(MP + 4 * b + t) * 512 + (kv * 4 + g) * 64 + d0) = pk2(a0, a1);
    }
    LBAR();
}

__device__ __forceinline__ float dn_ld(const bf16_t* Z, const float* cbuf, int row0, int tok, int cc) {
    return tok >= 0 ? bf2f(Z[(size_t)(row0 + tok) * NZ + ZDQ + cc]) : (cbuf ? cbuf[(3 + tok) * 1536 + cc] : 0.f);
}
template <int CG, int RS, int TB>
__device__ __forceinline__ void dn_scan_item(const Params& p, LAS unsigned char* lds, int row0, int L, int h, int cg, const float* S0, const float* cbuf, float* Sout, int tid) {
    static_assert(CG * RS == NTHR, "thread map");
    constexpr int R = 128 / RS;
    LAS float* sq = (LAS float*)lds;
    LAS float* sk = sq + TB * 128;
    LAS float* sv = sk + TB * 128;
    LAS float* sa = sv + TB * CG;
    LAS float* sb = sa + TB;
    const bf16_t* Z = (const bf16_t*)(p.ws + WS_Z);
    const float* cw = p.in[12];
    const float* gbuf = (const float*)(p.ws + WS_GB);
    bf16_t* oraw = (bf16_t*)(p.ws + WS_RA);
    const int c = tid / RS, rs = tid % RS;
    float S[R];
#pragma unroll
    for (int r = 0; r < R; ++r) S[r] = S0 ? S0[(size_t)(rs * R + r) * 128 + cg * CG + c] : 0.f;
    for (int t0 = 0; t0 < L; t0 += TB) {
        {
            const int ch = tid & 255, half = tid >> 8;
            const int cc = (ch < 128) ? (h * 128 + ch) : (512 + h * 128 + (ch - 128));
            const float w0 = cw[cc], w1 = cw[1536 + cc], w2 = cw[2 * 1536 + cc], w3 = cw[3 * 1536 + cc];
            constexpr int TH = TB / 2;
            const int tb = t0 + half * TH;
            float x0 = dn_ld(Z, cbuf, row0, tb - 3, cc), x1 = dn_ld(Z, cbuf, row0, tb - 2, cc), x2 = dn_ld(Z, cbuf, row0, tb - 1, cc);
            LAS float* dst = ((ch < 128) ? sq : sk) + (ch & 127);
#pragma unroll 4
            for (int i = 0; i < TH; ++i) { const float x3 = dn_ld(Z, cbuf, row0, tb + i, cc); dst[(half * TH + i) * 128] = silu(w0 * x0 + w1 * x1 + w2 * x2 + w3 * x3); x0 = x1; x1 = x2; x2 = x3; }
        }
        for (int e = tid; e < TB * CG; e += NTHR) { const int tt = e / CG, c2 = e % CG, cc = 1024 + h * 128 + cg * CG + c2, tok = t0 + tt;
            const float y = cw[cc] * dn_ld(Z, cbuf, row0, tok - 3, cc) + cw[1536 + cc] * dn_ld(Z, cbuf, row0, tok - 2, cc) + cw[2 * 1536 + cc] * dn_ld(Z, cbuf, row0, tok - 1, cc) + cw[3 * 1536 + cc] * dn_ld(Z, cbuf, row0, tok, cc);
            sv[tt * CG + c2] = silu(y); }
        if (tid < TB) { const size_t row = (size_t)(row0 + t0 + tid); sa[tid] = __expf(gbuf[row * 8 + h]); sb[tid] = gbuf[row * 8 + 4 + h]; }
        LBAR();
        for (int ri = tid >> 2; ri < 2 * TB; ri += NTHR / 4) {
            LAS float* rp = (ri < TB) ? (sq + ri * 128) : (sk + (ri - TB) * 128);
            const int sh = (tid & 3) + 4 * ri;
            float ss = 0.f;
#pragma unroll
            for (int i = 0; i < 32; ++i) { const float x = rp[(4 * i + sh) & 127]; ss += x * x; }
            ss += __shfl_xor(ss, 1); ss += __shfl_xor(ss, 2);
            const float scl = __builtin_amdgcn_rsqf(ss + EPS) * ((ri < TB) ? 0.08838834764831845f : 1.f);
#pragma unroll
            for (int i = 0; i < 32; ++i) rp[(4 * i + sh) & 127] *= scl;
        }
        LBAR();
        for (int tt = 0; tt < TB; ++tt) {
            const float a = sa[tt], bt = sb[tt], vv = sv[tt * CG + c];
            float kk[R]; float part = 0.f;
#pragma unroll
            for (int r = 0; r < R; ++r) { kk[r] = sk[tt * 128 + rs * R + r]; part += kk[r] * S[r]; }
#pragma unroll
            for (int o = 1; o < RS; o <<= 1) part += __shfl_xor(part, o);
            const float vn = bt * (vv - a * part);
            float op = 0.f;
#pragma unroll
            for (int r = 0; r < R; ++r) { S[r] = a * S[r] + kk[r] * vn; op += sq[tt * 128 + rs * R + r] * S[r]; }
#pragma unroll
            for (int o = 1; o < RS; o <<= 1) op += __shfl_xor(op, o);
            if (rs == 0) oraw[(size_t)(row0 + t0 + tt) * 512 + h * 128 + cg * CG + c] = (bf16_t)f2bf(op);
        }
        LBAR();
    }
#pragma unroll
    for (int r = 0; r < R; ++r) Sout[(size_t)(rs * R + r) * 128 + cg * CG + c] = S[r];
}


__device__ __forceinline__ bf16x8 frag64(const LAS bf16_t* ptr) {
    const s16x4 lo = *(const LAS s16x4*)ptr, hi = *(const LAS s16x4*)(ptr + 16);
    return __builtin_shufflevector(lo, hi, 0, 1, 2, 3, 4, 5, 6, 7);
}
__device__ __forceinline__ void dn_chunk_prep(const Params& p, LAS unsigned char* lds, int u, int tid, int lane, int wave) {
    const int n = u & 31, h = (u >> 5) & 3, b = u >> 7;
    const int row0 = b * 2048 + n * 64;
    LAS float* sq = (LAS float*)lds;
    LAS float* sk = sq + 64 * 128;
    LAS bf16_t* Kb = (LAS bf16_t*)(lds + 65536);
    LAS bf16_t* Qb = Kb + 64 * 136;
    LAS float* sgam = (LAS float*)(lds + 65536 + 2 * 17408);
    LAS float* sbeta = sgam + 64;
    LAS float* seg = sbeta + 64;
    LAS float* sek = seg + 64;
    LAS float* srq = sek + 64;
    LAS float* srk = srq + 64;
    LAS float* sA = sq;
    const bf16_t* Z = (const bf16_t*)(p.ws + WS_Z);
    const float* cw = p.in[12];
    const float* gbuf = (const float*)(p.ws + WS_GB);
    bf16_t* img = (bf16_t*)p.out + (size_t)u * 32768;
    bf16_t* mimg = (bf16_t*)(p.ws + WS_YB) + (size_t)u * 4096;
    const int type = wave >> 1, d = (wave & 1) * 64 + lane;
    float x[64];
    if (type < 3) {
        const int cc = type * 512 + h * 128 + d;
        const float w0 = cw[cc], w1 = cw[1536 + cc], w2 = cw[2 * 1536 + cc], w3 = cw[3 * 1536 + cc];
        const int tk = n * 64;
        const bf16_t* zrow = Z + ((size_t)(b * 2048 + tk) - 3) * NZ + ZDQ + type * 512 + h * 128 + (wave & 1) * 64;
        float x0 = 0.f, x1 = 0.f, x2 = 0.f;
        if (n > 0) { x0 = bf2f(zrow[lane]); x1 = bf2f(zrow[NZ + lane]); x2 = bf2f(zrow[2 * NZ + lane]); }
        zrow += 3 * NZ;
#pragma unroll
        for (int t8 = 0; t8 < 4; ++t8) {
#pragma unroll
            for (int e = 0; e < 16; ++e) { const float x3 = bf2f(zrow[lane]); zrow += NZ; x[16 * t8 + e] = silu(w0 * x0 + w1 * x1 + w2 * x2 + w3 * x3); x0 = x1; x1 = x2; x2 = x3; }
            asm volatile("" ::: "memory"); }
        if (type < 2) { LAS float* dst = (type ? sk : sq) + d;
#pragma unroll
            for (int t = 0; t < 64; ++t) dst[t * 128] = x[t]; }
    } else {
#pragma unroll
        for (int t = 0; t < 64; ++t) x[t] = 0.f;
        if (wave == 7) {
            float g = gbuf[(size_t)(row0 + lane) * 8 + h]; const float be = gbuf[(size_t)(row0 + lane) * 8 + 4 + h];
#pragma unroll
            for (int o = 1; o < 64; o <<= 1) { const float v = __shfl_up(g, o); if (lane >= o) g += v; }
            const float glast = __shfl(g, 63);
            sgam[lane] = g; sbeta[lane] = be; seg[lane] = __expf(g); sek[lane] = __expf(glast - g);
            if (lane == 0) ((float*)(p.ws + WS_GLAST))[u] = __expf(glast);
        }
    }
    LBAR();
    {
        const int ri = tid >> 2; LAS float* rp = (ri < 64) ? (sq + ri * 128) : (sk + (ri - 64) * 128);
        const int sh = (tid & 3) + 4 * ri; float ss = 0.f;
#pragma unroll
        for (int i = 0; i < 32; ++i) { const float v = rp[(4 * i + sh) & 127]; ss += v * v; }
        ss += __shfl_xor(ss, 1); ss += __shfl_xor(ss, 2);
        if ((tid & 3) == 0) { if (ri < 64) srq[ri] = __builtin_amdgcn_rsqf(ss + EPS) * 0.08838834764831845f; else srk[ri - 64] = __builtin_amdgcn_rsqf(ss + EPS); }
    }
    LBAR();
    {
        int vz; asm volatile("v_mov_b32 %0, 0" : "=v"(vz));
        if (type == 0) {
#pragma unroll
            for (int t8 = 0; t8 < 8; ++t8) {
#pragma unroll
                for (int e = 0; e < 8; ++e) { const int t = 8 * t8 + e; const float v = x[t] * srq[t + vz]; Qb[t * 136 + d] = (bf16_t)f2bf(v); img[8192 + t * 128 + d] = (bf16_t)f2bf(v * seg[t + vz]); }
                asm volatile("" ::: "memory"); }
        } else if (type == 1) {
            bf16_t* kd = img + 16384 + d * 64;
#pragma unroll
            for (int t8 = 0; t8 < 8; ++t8) { float v[8];
#pragma unroll
                for (int e = 0; e < 8; ++e) { const int t = 8 * t8 + e; const float kv = x[t] * srk[t + vz]; Kb[t * 136 + d] = (bf16_t)f2bf(kv); v[e] = kv * sek[t + vz]; x[t] = kv * sbeta[t + vz] * seg[t + vz]; }
                u32x4 w; w.x = pk2(v[0], v[1]); w.y = pk2(v[2], v[3]); w.z = pk2(v[4], v[5]); w.w = pk2(v[6], v[7]); *(u32x4*)(kd + 8 * t8) = w;
                asm volatile("" ::: "memory"); }
        } else if (type == 2) {
#pragma unroll
            for (int t8 = 0; t8 < 8; ++t8) {
#pragma unroll
                for (int e = 0; e < 8; ++e) x[8 * t8 + e] *= sbeta[8 * t8 + e + vz];
                asm volatile("" ::: "memory"); }
        }
    }
    LBAR();
    {
        const int it = wave & 3, kind = wave >> 2; const int l15 = lane & 15, q4 = lane >> 4;
        const LAS bf16_t* Ab = kind ? Qb : Kb;
        bf16x8 af[4];
#pragma unroll
        for (int ks = 0; ks < 4; ++ks) af[ks] = *(const LAS bf16x8*)(Ab + (16 * it + l15) * 136 + 32 * ks + 8 * q4);
#pragma unroll 1
        for (int jt = 0; jt < 4; ++jt) {
            f32x4 c = (f32x4){0.f, 0.f, 0.f, 0.f};
            if (jt <= it) {
#pragma unroll
                for (int ks = 0; ks < 4; ++ks) { const bf16x8 bfm = *(const LAS bf16x8*)(Kb + (16 * jt + l15) * 136 + 32 * ks + 8 * q4); c = MFMA16(af[ks], bfm, c); }
            }
            const int j = 16 * jt + l15; const float gj = sgam[j];
            f32x4 val;
#pragma unroll
            for (int r = 0; r < 4; ++r) { const int i = 16 * it + 4 * q4 + r; const float dec = __expf(fminf(sgam[i] - gj, 0.f));
                const float bi = kind ? 1.f : sbeta[i]; const bool keep = kind ? (i >= j) : (i > j);
                val[r] = keep ? bi * c[r] * dec : 0.f; }
            if (kind == 0) {
#pragma unroll
                for (int r = 0; r < 4; ++r) sA[(16 * it + 4 * q4 + r) * 64 + j] = val[r];
            } else {
#pragma unroll
                for (int r = 0; r < 4; ++r) mimg[(16 * it + 4 * q4 + r) * 64 + j] = (bf16_t)f2bf(val[r]);
            }
        }
    }
    LBAR();
    if (type == 1 || type == 2) {
#pragma unroll
        for (int i = 1; i < 64; ++i) { const LAS float* ar = sA + i * 64; f32x2 s01 = (f32x2){0.f, 0.f}, s23 = (f32x2){0.f, 0.f};
#pragma unroll
            for (int j = 0; j + 1 < i; j += 2) { const f32x2 av = (f32x2){ar[j], ar[j + 1]}, xv = (f32x2){x[j], x[j + 1]};
                if ((j & 2) == 0) s01 = __builtin_elementwise_fma(av, xv, s01); else s23 = __builtin_elementwise_fma(av, xv, s23); }
            float tail = 0.f; if (i & 1) tail = ar[i - 1] * x[i - 1];
            x[i] = x[i] - (((s01[0] + s01[1]) + (s23[0] + s23[1])) + tail); }
        if (type == 1) {
#pragma unroll
            for (int t = 0; t < 64; ++t) img[t * 128 + d] = (bf16_t)f2bf(x[t]);
        } else { bf16_t* ut = img + 24576 + d * 64;
#pragma unroll
            for (int t8 = 0; t8 < 8; ++t8) { u32x4 w; w.x = pk2(x[8 * t8], x[8 * t8 + 1]); w.y = pk2(x[8 * t8 + 2], x[8 * t8 + 3]); w.z = pk2(x[8 * t8 + 4], x[8 * t8 + 5]); w.w = pk2(x[8 * t8 + 6], x[8 * t8 + 7]); *(u32x4*)(ut + 8 * t8) = w; }
        }
    }
    LBAR();
}

constexpr int DN_IMG_ELEMS = 2 * 64 * 136 + 2 * 128 * 72 + 64 * 72;
__device__ __forceinline__ void dn_scan_chunked(const Params& p, LAS unsigned char* lds, int bh, int half, int tid, int lane, int wave) {
    const int b = bh >> 2, h = bh & 3;
    const bf16_t* img = (const bf16_t*)p.out + (size_t)bh * 32 * 32768;
    const bf16_t* mimg = (const bf16_t*)(p.ws + WS_YB) + (size_t)bh * 32 * 4096;
    const float* gl = (const float*)(p.ws + WS_GLAST) + bh * 32;
    bf16_t* oraw = (bf16_t*)(p.ws + WS_RA);
    const int l15 = lane & 15, q4 = lane >> 4, cb = half * 4 + (wave & 3);
    const bool active = wave < 4;
    u32x4 preA[9], preB[9];
#define DN_LOAD(pre, nn) do { _Pragma("unroll") for (int i = 0; i < 8; ++i) pre[i] = *(const u32x4*)(img + (size_t)(nn) * 32768 + (size_t)(tid + 512 * i) * 8); \
        pre[8] = *(const u32x4*)(mimg + (size_t)(nn) * 4096 + tid * 8); } while (0)
#define DN_STORE(buf, pre) do { LAS bf16_t* sW_ = (LAS bf16_t*)lds + (buf) * DN_IMG_ELEMS; LAS bf16_t* sQd_ = sW_ + 64 * 136; LAS bf16_t* sKdT_ = sQd_ + 64 * 136; LAS bf16_t* sUT_ = sKdT_ + 128 * 72; LAS bf16_t* sM_ = sUT_ + 128 * 72; \
        _Pragma("unroll") for (int i = 0; i < 8; ++i) { const int ee = tid * 8 + 4096 * (i & 1); \
            LAS bf16_t* dst = (i < 2) ? (sW_ + (ee >> 7) * 136 + (ee & 127)) : (i < 4) ? (sQd_ + (ee >> 7) * 136 + (ee & 127)) : (i < 6) ? (sKdT_ + (ee >> 6) * 72 + (ee & 63)) : (sUT_ + (ee >> 6) * 72 + (ee & 63)); \
            *(LAS u32x4*)dst = pre[i]; } \
        { const int ee = tid * 8; *(LAS u32x4*)(sM_ + (ee >> 6) * 72 + (ee & 63)) = pre[8]; } } while (0)
#define DN_BAR() do { asm volatile("s_waitcnt lgkmcnt(0)" ::: "memory"); __builtin_amdgcn_s_barrier(); asm volatile("" ::: "memory"); } while (0)
    f32x4 S[8];
#pragma unroll
    for (int i = 0; i < 8; ++i) S[i] = (f32x4){0.f, 0.f, 0.f, 0.f};
#define DN_STEP(n, cur) do { if (active) { __builtin_amdgcn_s_setprio(2); \
        const LAS bf16_t* sW = (const LAS bf16_t*)lds + (cur) * DN_IMG_ELEMS; const LAS bf16_t* sQd = sW + 64 * 136; const LAS bf16_t* sKdT = sQd + 64 * 136; const LAS bf16_t* sUT = sKdT + 128 * 72; const LAS bf16_t* sM = sUT + 128 * 72; \
        const float glast = gl[(n)]; \
        bf16x8 Sb[4]; \
        _Pragma("unroll") for (int s_ = 0; s_ < 4; ++s_) Sb[s_] = pack_p(S[2 * s_], S[2 * s_ + 1]); \
        f32x4 Vn[4], O[4]; \
        _Pragma("unroll") for (int rt = 0; rt < 4; ++rt) { \
            f32x4 p1 = (f32x4){0.f, 0.f, 0.f, 0.f}, oo = (f32x4){0.f, 0.f, 0.f, 0.f}; \
            _Pragma("unroll") for (int s_ = 0; s_ < 4; ++s_) { p1 = MFMA16(frag64(sW + (16 * rt + l15) * 136 + 32 * s_ + 4 * q4), Sb[s_], p1); oo = MFMA16(frag64(sQd + (16 * rt + l15) * 136 + 32 * s_ + 4 * q4), Sb[s_], oo); } \
            const s16x4 u4 = *(const LAS s16x4*)(sUT + (16 * cb + l15) * 72 + 16 * rt + 4 * q4); \
            Vn[rt] = (f32x4){bf2f((unsigned short)u4[0]), bf2f((unsigned short)u4[1]), bf2f((unsigned short)u4[2]), bf2f((unsigned short)u4[3])} - p1; O[rt] = oo; } \
        bf16x8 Vb[2]; Vb[0] = pack_p(Vn[0], Vn[1]); Vb[1] = pack_p(Vn[2], Vn[3]); \
        _Pragma("unroll") for (int rt = 0; rt < 4; ++rt) _Pragma("unroll") for (int s2 = 0; s2 < 2; ++s2) O[rt] = MFMA16(frag64(sM + (16 * rt + l15) * 72 + 32 * s2 + 4 * q4), Vb[s2], O[rt]); \
        _Pragma("unroll") for (int dkb = 0; dkb < 8; ++dkb) { f32x4 acc = S[dkb] * glast; \
            _Pragma("unroll") for (int s2 = 0; s2 < 2; ++s2) acc = MFMA16(frag64(sKdT + (16 * dkb + l15) * 72 + 32 * s2 + 4 * q4), Vb[s2], acc); \
            S[dkb] = acc; } \
        _Pragma("unroll") for (int rt = 0; rt < 4; ++rt) _Pragma("unroll") for (int r = 0; r < 4; ++r) oraw[(size_t)(b * 2048 + 64 * (n) + 16 * rt + 4 * q4 + r) * 512 + h * 128 + 16 * cb + l15] = (bf16_t)f2bf(O[rt][r]); \
    __builtin_amdgcn_s_setprio(0); } } while (0)
    DN_LOAD(preA, 0); DN_STORE(0, preA);
    DN_LOAD(preA, 1); DN_LOAD(preB, 2);
    DN_BAR();
#pragma unroll 1
    for (int n = 0; n < 32; n += 2) {
        DN_STORE(1, preA);
        if (n + 3 < 32) DN_LOAD(preA, n + 3);
        DN_STEP(n, 0);
        DN_BAR();
        if (n + 2 < 32) DN_STORE(0, preB);
        if (n + 4 < 32) DN_LOAD(preB, n + 4);
        DN_STEP(n + 1, 1);
        DN_BAR();
    }
#undef DN_STEP
#undef DN_BAR
#undef DN_LOAD
#undef DN_STORE
    float* so = p.out + O_PDS + (size_t)bh * 16384;
    if (active)
#pragma unroll
    for (int dkb = 0; dkb < 8; ++dkb)
#pragma unroll
        for (int r = 0; r < 4; ++r) so[(size_t)(16 * dkb + 4 * q4 + r) * 128 + 16 * cb + l15] = S[dkb][r];
}


template <int K, class F1, int LDA = K>
__device__ __forceinline__ void skinny_sample_gemm(const bf16_t* A  , const bf16_t* Bt  , int bid, int G, int lane, int wave, const F1& f1) {
    const int l15 = lane & 15, q4 = lane >> 4;
    for (int t = bid; t < 256; t += G) {
        const int rg = t >> 3, cgp = t & 7;
        const bf16_t* ap = A + (size_t)(16 * rg + l15) * LDA + 8 * q4;
        const bf16_t* bp = Bt + (size_t)(128 * cgp + 16 * wave + l15) * K + 8 * q4;
        f32x4 acc = (f32x4){0.f, 0.f, 0.f, 0.f};
#pragma unroll 8
        for (int ks = 0; ks < K / 32; ++ks) { const bf16x8 a = *(const bf16x8*)(ap + 32 * ks), b = *(const bf16x8*)(bp + 32 * ks); acc = MFMA16(a, b, acc); }
        const int col = 128 * cgp + 16 * wave + l15;
#pragma unroll
        for (int r = 0; r < 4; ++r) f1(MP + 16 * rg + 4 * q4 + r, col, acc[r]);
    }
}
struct FGateA1 { const bf16_t* Z; bf16_t* t1;
    __device__ __forceinline__ void operator()(int row, int col, float v) const { t1[(size_t)row * 1024 + col] = (bf16_t)f2bf(sigm(bf2f(Z[(size_t)row * NZ + ZGA + col])) * v); } };
struct FGateB1 { const bf16_t* Z; const bf16_t* t1; bf16_t* mix;
    __device__ __forceinline__ void operator()(int row, int col, float v) const { mix[(size_t)row * 1024 + col] = (bf16_t)f2bf(bf2f(t1[(size_t)row * 1024 + col]) + sigm(bf2f(Z[(size_t)row * NZ + ZGB + col])) * v); } };
struct FResX1 { const float* xs; float* h;
    __device__ __forceinline__ void operator()(int row, int col, float v) const { h[(size_t)row * 1024 + col] = xs[(size_t)(row - MP) * 1024 + col] + v; } };
struct FAcc1 { float* h;
    __device__ __forceinline__ void operator()(int row, int col, float v) const { h[(size_t)row * 1024 + col] += v; } };

__device__ __forceinline__ void xattn_stage(LAS unsigned char* lds, const float* kb, const float* vb, int h, int tid) {
    LAS bf16_t* sK = (LAS bf16_t*)lds;
    LAS bf16_t* sVt = (LAS bf16_t*)(lds + 69632);
    const int key = tid >> 1, half = tid & 1;
    const float* kr = kb + ((size_t)key * 4 + h) * 128 + 64 * half;
    const float* vr = vb + ((size_t)key * 4 + h) * 128 + 64 * half;
#pragma unroll
    for (int i = 0; i < 8; ++i) { const f32x4 a = *(const f32x4*)(kr + 8 * i), b2 = *(const f32x4*)(kr + 8 * i + 4);
        u32x4 w; w.x = pk2(a[0], a[1]); w.y = pk2(a[2], a[3]); w.z = pk2(b2[0], b2[1]); w.w = pk2(b2[2], b2[3]);
        *(LAS u32x4*)(sK + key * 136 + 64 * half + 8 * i) = w; }
#pragma unroll
    for (int i = 0; i < 16; ++i) { const f32x4 a = *(const f32x4*)(vr + 4 * i);
#pragma unroll
        for (int e = 0; e < 4; ++e) sVt[(64 * half + 4 * i + e) * 264 + key] = (bf16_t)f2bf(a[e]); }
}
template <int NQB>
__device__ __forceinline__ void xattn_wave(const Params& p, const LAS unsigned char* lds, int rowbase, int nvalid, int h, int lane) {
    const LAS bf16_t* sK = (const LAS bf16_t*)lds;
    const LAS bf16_t* sVt = (const LAS bf16_t*)(lds + 69632);
    const bf16_t* hq = (const bf16_t*)(p.ws + WS_Z + ZO_HQ);
    bf16_t* xo = (bf16_t*)(p.ws + WS_Z + ZO_XO);
    const int l15 = lane & 15, q4 = lane >> 4;
    const int lr = (l15 < nvalid) ? l15 : (nvalid - 1);
    bf16x8 qf[NQB][4];
#pragma unroll
    for (int qb = 0; qb < NQB; ++qb)
#pragma unroll
        for (int ks = 0; ks < 4; ++ks) qf[qb][ks] = *(const bf16x8*)(hq + (size_t)(rowbase + 16 * qb + lr) * 512 + h * 128 + 32 * ks + 8 * q4);
    f32x4 o[8][NQB]; float mrow[NQB], lrow[NQB];
#pragma unroll
    for (int qb = 0; qb < NQB; ++qb) { mrow[qb] = -1e30f; lrow[qb] = 0.f;
#pragma unroll
        for (int db = 0; db < 8; ++db) o[db][qb] = (f32x4){0.f, 0.f, 0.f, 0.f}; }
    for (int kt = 0; kt < 4; ++kt) {
        f32x4 s[4][NQB];
#pragma unroll
        for (int kb = 0; kb < 4; ++kb) {
            const LAS bf16_t* kr = sK + (64 * kt + 16 * kb + l15) * 136 + 8 * q4;
#pragma unroll
            for (int qb = 0; qb < NQB; ++qb) s[kb][qb] = (f32x4){0.f, 0.f, 0.f, 0.f};
#pragma unroll
            for (int ks = 0; ks < 4; ++ks) { const bf16x8 kf = *(const LAS bf16x8*)(kr + 32 * ks);
#pragma unroll
                for (int qb = 0; qb < NQB; ++qb) s[kb][qb] = MFMA16(kf, qf[qb][ks], s[kb][qb]); }
        }
#pragma unroll
        for (int qb = 0; qb < NQB; ++qb) {
            float mx = -1e30f;
#pragma unroll
            for (int kb = 0; kb < 4; ++kb)
#pragma unroll
                for (int r = 0; r < 4; ++r) { const float v = s[kb][qb][r] * 0.08838834764831845f; s[kb][qb][r] = v; mx = fmaxf(mx, v); }
            mx = fmaxf(mx, __shfl_xor(mx, 16)); mx = fmaxf(mx, __shfl_xor(mx, 32));
            const float mn = fmaxf(mrow[qb], mx), alpha = __expf(mrow[qb] - mn); mrow[qb] = mn;
            float ls = lrow[qb] * alpha;
#pragma unroll
            for (int db = 0; db < 8; ++db) o[db][qb] = o[db][qb] * alpha;
#pragma unroll
            for (int kb = 0; kb < 4; ++kb)
#pragma unroll
                for (int r = 0; r < 4; ++r) { const float pv = __expf(s[kb][qb][r] - mn); ls += pv; s[kb][qb][r] = pv; }
            lrow[qb] = ls;
        }
#pragma unroll
        for (int s2 = 0; s2 < 2; ++s2) {
            bf16x8 pb[NQB];
#pragma unroll
            for (int qb = 0; qb < NQB; ++qb) pb[qb] = pack_p(s[2 * s2][qb], s[2 * s2 + 1][qb]);
#pragma unroll
            for (int db = 0; db < 8; ++db) {
                const LAS bf16_t* vr = sVt + (16 * db + l15) * 264 + 64 * kt + 32 * s2 + 4 * q4;
                const s16x4 lo = *(const LAS s16x4*)vr, hi = *(const LAS s16x4*)(vr + 16);
                const bf16x8 vf = __builtin_shufflevector(lo, hi, 0, 1, 2, 3, 4, 5, 6, 7);
#pragma unroll
                for (int qb = 0; qb < NQB; ++qb) o[db][qb] = MFMA16(vf, pb[qb], o[db][qb]);
            }
        }
    }
#pragma unroll
    for (int qb = 0; qb < NQB; ++qb) {
        float lt = lrow[qb]; lt += __shfl_xor(lt, 16); lt += __shfl_xor(lt, 32); const float inv = __builtin_amdgcn_rcpf(lt);
        if (l15 < nvalid) { const size_t row = (size_t)(rowbase + 16 * qb + l15);
#pragma unroll
            for (int db = 0; db < 8; ++db) { u32x2 w; w.x = pk2(o[db][qb][0] * inv, o[db][qb][1] * inv); w.y = pk2(o[db][qb][2] * inv, o[db][qb][3] * inv);
                *(u32x2*)(xo + row * 512 + h * 128 + 16 * db + 4 * q4) = w; } }
    }
}

template <bool FINAL>
__device__ __forceinline__ void rms_pass(const Params& p, const float* g, int gw, int NGW, int lane) {
    bf16_t* hn = (bf16_t*)(p.ws + WS_RA);
    for (int m = gw; m < MT; m += 2 * NGW) {
        const int mb = (m + NGW < MT) ? (m + NGW) : m;
        f32x4* xa = (f32x4*)(p.out + (size_t)m * 1024); f32x4* xb = (f32x4*)(p.out + (size_t)mb * 1024);
        f32x4 va[4], vb[4]; float sa = 0.f, sb = 0.f;
#pragma unroll
        for (int j = 0; j < 4; ++j) { va[j] = xa[lane + 64 * j]; vb[j] = xb[lane + 64 * j]; }
#pragma unroll
        for (int j = 0; j < 4; ++j) { sa += (va[j][0] * va[j][0] + va[j][1] * va[j][1]) + (va[j][2] * va[j][2] + va[j][3] * va[j][3]); sb += (vb[j][0] * vb[j][0] + vb[j][1] * vb[j][1]) + (vb[j][2] * vb[j][2] + vb[j][3] * vb[j][3]); }
#pragma unroll
        for (int o = 1; o < 64; o <<= 1) { sa += __shfl_xor(sa, o); sb += __shfl_xor(sb, o); }
        const float ra = __builtin_amdgcn_rsqf(sa * (1.f / 1024.f) + EPS), rb = __builtin_amdgcn_rsqf(sb * (1.f / 1024.f) + EPS);
#pragma unroll
        for (int j = 0; j < 4; ++j) { const f32x4 gg = ((const f32x4*)g)[lane + 64 * j]; const f32x4 ya = va[j] * ra * gg, yb = vb[j] * rb * gg;
            if constexpr (FINAL) { xa[lane + 64 * j] = ya; if (mb != m) xb[lane + 64 * j] = yb; }
            else { u32x2 w; w.x = pk2(ya[0], ya[1]); w.y = pk2(ya[2], ya[3]); ((u32x2*)(hn + (size_t)m * 1024))[lane + 64 * j] = w;
                   u32x2 w2; w2.x = pk2(yb[0], yb[1]); w2.y = pk2(yb[2], yb[3]); ((u32x2*)(hn + (size_t)mb * 1024))[lane + 64 * j] = w2; } }
    }
}

__device__ __forceinline__ void ffn_gate_chunk(const Params& p, int row_lo, int nrows, int gtid, int GT) {
    const bf16_t* UG = (const bf16_t*)(p.ws + WS_Z + ZO_UG);
    bf16_t* act = (bf16_t*)(p.ws + WS_Z + ZO_UG) + 2816;
    const float* fcw = p.in[27]; const float* sfc = p.in[9];
    const int np = (row_lo + nrows > MP) ? (MP - row_lo) : nrows;
    for (int it = gtid; it < (np >> 3) * 352; it += GT) {
        const int lr0 = (it / 352) * 8, c = (it % 352) * 8, t0 = (row_lo + lr0) & 2047, bs = (row_lo + lr0) >> 11;
        const bf16_t* ub = UG + (size_t)lr0 * 5632 + c;
        u32x4 uu[8], gg[8], h1 = (u32x4){0u, 0u, 0u, 0u}, h0 = (u32x4){0u, 0u, 0u, 0u};
        if (t0 != 0) { h1 = *(const u32x4*)(ub - 5632); h0 = *(const u32x4*)(ub - 2 * 5632); }
#pragma unroll
        for (int i = 0; i < 8; ++i) { uu[i] = *(const u32x4*)(ub + (size_t)i * 5632); gg[i] = *(const u32x4*)(ub + (size_t)i * 5632 + 2816); }
        const f32x4 wa0 = *(const f32x4*)(fcw + c), wa1 = *(const f32x4*)(fcw + c + 4), wb0 = *(const f32x4*)(fcw + 2816 + c), wb1 = *(const f32x4*)(fcw + 2816 + c + 4), wc0 = *(const f32x4*)(fcw + 2 * 2816 + c), wc1 = *(const f32x4*)(fcw + 2 * 2816 + c + 4);
#pragma unroll
        for (int i = 0; i < 8; ++i) {
            const u32x4 x2 = uu[i]; u32x4 o;
#pragma unroll
            for (int w = 0; w < 4; ++w) {
                const float k0 = (w < 2) ? wa0[2 * (w & 1)] : wa1[2 * (w & 1)], k0b = (w < 2) ? wa0[2 * (w & 1) + 1] : wa1[2 * (w & 1) + 1];
                const float k1 = (w < 2) ? wb0[2 * (w & 1)] : wb1[2 * (w & 1)], k1b = (w < 2) ? wb0[2 * (w & 1) + 1] : wb1[2 * (w & 1) + 1];
                const float k2 = (w < 2) ? wc0[2 * (w & 1)] : wc1[2 * (w & 1)], k2b = (w < 2) ? wc0[2 * (w & 1) + 1] : wc1[2 * (w & 1) + 1];
                const float ya = k0 * bflo(h0[w]) + k1 * bflo(h1[w]) + k2 * bflo(x2[w]), yb2 = k0b * bfhi(h0[w]) + k1b * bfhi(h1[w]) + k2b * bfhi(x2[w]);
                o[w] = pk2(silu(ya) * bflo(gg[i][w]), silu(yb2) * bfhi(gg[i][w])); }
            *(u32x4*)(act + (size_t)(row_lo + lr0 + i) * 5632 + c) = o;
            if (t0 + i >= 2046) { float* od = p.out + O_PFC + ((size_t)bs * 2 + (t0 + i - 2046)) * 2816 + c;
                *(f32x4*)od = (f32x4){bflo(x2[0]), bfhi(x2[0]), bflo(x2[1]), bfhi(x2[1])}; *(f32x4*)(od + 4) = (f32x4){bflo(x2[2]), bfhi(x2[2]), bflo(x2[3]), bfhi(x2[3])}; }
            h0 = h1; h1 = x2;
        }
    }
    const int items = (nrows - np) * 352;
    for (int it = gtid; it < items; it += GT) {
        const int lr = np + it / 352, c = (it % 352) * 8, r = row_lo + lr;
        const bool samp = true; const int t = (r - MP) & 3; const int bs = (r - MP) >> 2;
        const u32x4 u0 = *(const u32x4*)(UG + (size_t)lr * 5632 + c), gv = *(const u32x4*)(UG + (size_t)lr * 5632 + 2816 + c);
        float x0[8], x1[8], x2[8], gvf[8];
#pragma unroll
        for (int w = 0; w < 4; ++w) { x2[2 * w] = bflo(u0[w]); x2[2 * w + 1] = bfhi(u0[w]); gvf[2 * w] = bflo(gv[w]); gvf[2 * w + 1] = bfhi(gv[w]); }
        if (t >= 1) { const u32x4 a = *(const u32x4*)(UG + (size_t)(lr - 1) * 5632 + c);
#pragma unroll
            for (int w = 0; w < 4; ++w) { x1[2 * w] = bflo(a[w]); x1[2 * w + 1] = bfhi(a[w]); } }
        else { const float* s = sfc + ((size_t)bs * 2 + 1) * 2816 + c;
#pragma unroll
            for (int e = 0; e < 8; ++e) x1[e] = s[e]; }
        if (t >= 2) { const u32x4 a = *(const u32x4*)(UG + (size_t)(lr - 2) * 5632 + c);
#pragma unroll
            for (int w = 0; w < 4; ++w) { x0[2 * w] = bflo(a[w]); x0[2 * w + 1] = bfhi(a[w]); } }
        else { const float* s = sfc + ((size_t)bs * 2 + t) * 2816 + c;
#pragma unroll
            for (int e = 0; e < 8; ++e) x0[e] = s[e]; }
        float a8[8];
#pragma unroll
        for (int e = 0; e < 8; ++e) { const float y = fcw[c + e] * x0[e] + fcw[2816 + c + e] * x1[e] + fcw[2 * 2816 + c + e] * x2[e]; a8[e] = silu(y) * gvf[e]; }
        u32x4 o; o.x = pk2(a8[0], a8[1]); o.y = pk2(a8[2], a8[3]); o.z = pk2(a8[4], a8[5]); o.w = pk2(a8[6], a8[7]);
        *(u32x4*)(act + (size_t)(row_lo + lr) * 5632 + c) = o;
        if (samp && t >= 2) { float* od = p.out + O_SFC + ((size_t)bs * 2 + (t - 2)) * 2816 + c;
            *(f32x4*)od = (f32x4){x2[0], x2[1], x2[2], x2[3]}; *(f32x4*)(od + 4) = (f32x4){x2[4], x2[5], x2[6], x2[7]}; }
    }
}

#define XB_TMO      128
#define XB_XCNT(j)  (256  + 64 * (j))
#define XB_XSUB(j)  (1280 + 64 * (j))
#define XB_XGEN(j)  (2304 + 64 * (j))
#define XB_TOP      3328
#define XB_TOPGEN   3392
#define XCD_BAR_WORDS 3456
#define XB_SPIN_CAP (1u << 18)

__device__ __forceinline__ unsigned xb_ld(unsigned* p)              { return __hip_atomic_load(p, __ATOMIC_RELAXED, __HIP_MEMORY_SCOPE_AGENT); }
__device__ __forceinline__ unsigned xb_add(unsigned* p, unsigned v) { return __hip_atomic_fetch_add(p, v, __ATOMIC_RELAXED, __HIP_MEMORY_SCOPE_AGENT); }
__device__ __forceinline__ unsigned xb_xcc_id() { return (unsigned)__builtin_amdgcn_s_getreg((3 << 11) | 20) & 0xFu; }
#define XB_SPIN(cond, bar) do { unsigned _sp = 0; while (cond) { __builtin_amdgcn_s_sleep(1); \
    if ((++_sp & 255u) == 0u) { if (xb_ld(&(bar)[XB_TMO])) break; if (_sp > XB_SPIN_CAP) { atomicAdd(&(bar)[XB_TMO], 1u); break; } } } } while (0)

struct XcdBarrier {
    unsigned* bar; unsigned x;
    volatile LAS unsigned* st;
};

__device__ __forceinline__ XcdBarrier xcd_barrier_post(unsigned* bar, volatile LAS unsigned* st) {
    XcdBarrier b; b.bar = bar; b.x = xb_xcc_id(); b.st = st;
    if (threadIdx.x == 0) (void)xb_add(&bar[XB_XCNT(b.x)], 1u);
    return b;
}
__device__ __forceinline__ void xcd_barrier_complete(unsigned* bar, unsigned x, unsigned& nloc, unsigned& nx) {
    const unsigned G = gridDim.x * gridDim.y * gridDim.z;
    unsigned sum, cnt, mine, sp = 0u;
    for (;;) {
        sum = 0u; cnt = 0u; mine = 0u;
#pragma unroll
        for (unsigned j = 0; j < 16; ++j) { const unsigned c = xb_ld(&bar[XB_XCNT(j)]); sum += c; cnt += (c > 0u) ? 1u : 0u; mine = (j == x) ? c : mine; }
        if (sum == G) break;
        __builtin_amdgcn_s_sleep(1);
        if ((++sp & 255u) == 0u) { if (xb_ld(&bar[XB_TMO])) break; if (sp > XB_SPIN_CAP) { atomicAdd(&bar[XB_TMO], 1u); break; } }
    }
    nloc = mine > 0u ? mine : 1u; nx = cnt > 0u ? cnt : 1u;
}

__device__ __attribute__((noinline)) void xcd_barrier(unsigned* bar_, unsigned x_, volatile LAS unsigned* st_) {
    XcdBarrier b; b.bar = bar_; b.x = x_; b.st = st_;
    asm volatile("s_waitcnt vmcnt(0)" ::: "memory");
    __syncthreads();
    if (threadIdx.x == 0) {
        unsigned* bar = b.bar;
        __builtin_amdgcn_s_waitcnt(0);
        unsigned nloc = b.st[0], nx = b.st[1];
        if (nloc == 0u) { xcd_barrier_complete(bar, b.x, nloc, nx); b.st[0] = nloc; b.st[1] = nx; }
        const unsigned old = xb_add(&bar[XB_XSUB(b.x)], 1u);
        const unsigned gen = old / nloc;
        if (old + 1u == (gen + 1u) * nloc) {
            __builtin_amdgcn_fence(__ATOMIC_RELEASE, "agent");
            asm volatile("s_waitcnt vmcnt(0)" ::: "memory");
            const unsigned og = xb_add(&bar[XB_TOP], 1u);
            const unsigned tg = og / nx;
            if (og + 1u == (tg + 1u) * nx) xb_add(&bar[XB_TOPGEN], 1u);
            else XB_SPIN(xb_ld(&bar[XB_TOPGEN]) == tg, bar);
            __builtin_amdgcn_fence(__ATOMIC_ACQUIRE, "agent");
            xb_add(&bar[XB_XGEN(b.x)], 1u);
            asm volatile("s_waitcnt vmcnt(0)" ::: "memory");
        } else {
            XB_SPIN(xb_ld(&bar[XB_XGEN(b.x)]) == gen, bar);
            __builtin_amdgcn_fence(__ATOMIC_ACQUIRE, "agent");
            asm volatile("s_waitcnt vmcnt(0)" ::: "memory");
        }
    }
    __syncthreads();
}

__global__ void __launch_bounds__(NTHR, 2) mega_fwd(Params p) {
    extern __shared__ __attribute__((aligned(16))) unsigned char lds_raw[];
    LAS unsigned char* lds = (LAS unsigned char*)lds_raw;
    cg::grid_group grid = cg::this_grid();
#define PH_IDS() int tid = threadIdx.x; asm volatile("" : "+v"(tid)); const int lane = tid & 63, wave = __builtin_amdgcn_readfirstlane(tid >> 6); \
    const int G = gridDim.x, bid = blockIdx.x; const int gw = bid * 8 + wave, NGW = G * 8, gtid = bid * NTHR + tid, GT = G * NTHR; \
    unsigned char* ws = p.ws; bf16_t* RA = (bf16_t*)(ws + WS_RA); bf16_t* Zb = (bf16_t*)(ws + WS_Z); float* hres = p.out; \
    (void)lane; (void)wave; (void)G; (void)bid; (void)gw; (void)NGW; (void)gtid; (void)GT; (void)RA; (void)Zb; (void)hres
#define BST() ((volatile LAS unsigned*)(lds + LDS_BYTES - 16))
#define GSYNC() xcd_barrier((unsigned*)(p.ws + WS_CTL), xb_xcc_id(), BST())
    {
        if (threadIdx.x == 0) { BST()[0] = 0u; BST()[1] = 0u; }
        __syncthreads();
        (void)xcd_barrier_post((unsigned*)(p.ws + WS_CTL), BST());
    }

    { PH_IDS();
    p0_prologue(p, lds, tid, lane, wave, G);
    }
    GSYNC();

    { PH_IDS();
    { pg8::Gemm g{RA, (const bf16_t*)(ws + WS_WIN), MT, NZ, 1024, 1024}; pg8::StaticOrder S; S.init(MT, NZ, G, bid);
      pg8::EpiBf16 E{Zb, NZ};
      pg8::gemm_phase<pg8::EpiBf16, pg8::StaticOrder, true, true>(lds, g, S, E); }
    { const int tb1 = (G == 256) ? 230 : 0;
      if (bid >= tb1) { LAS float* scr = (LAS float*)(lds + wave * 16384);
        constexpr int J5 = 16 * 32, J6 = 16 * 16, J3 = 8 * 32;
        for (int it = (bid - tb1) * 8 + wave; it < J5 + J6 + J5 + J3; it += (G - tb1) * 8) { int r = it;
            if (r < J5) { transpose_item(p.in[19], 1024, 0, 1024, 1024, (bf16_t*)(ws + WS_WMO), 0, scr, r, lane); continue; } r -= J5;
            if (r < J6) { transpose_item(p.in[22], 512, 0, 1024, 512, (bf16_t*)(ws + WS_WXQ), 0, scr, r, lane); continue; } r -= J6;
            if (r < J5) { transpose_item(p.in[23], 1024, 0, 1024, 1024, (bf16_t*)(ws + WS_WXKV), 0, scr, r, lane); continue; } r -= J5;
            transpose_item(p.in[24], 1024, 0, 512, 1024, (bf16_t*)(ws + WS_WXO), 0, scr, r, lane); } } }
    }
    GSYNC();

    { PH_IDS();
    for (int u = bid; u < 1024; u += G) dn_chunk_prep(p, lds, u, tid, lane, wave);
    }
    GSYNC();

    { PH_IDS();
    {
        const int nA = (G >= 128) ? 64 : G / 2;
        if (bid < nA) {
            for (int it = bid; it < 64; it += nA) dn_scan_chunked(p, lds, (it & 7) + 8 * (it >> 4), (it >> 3) & 1, tid, lane, wave);
        } else {
            const int idx = bid - nA, nB = G - nA;
            for (int it = idx; it < 256; it += nB) swa_prompt_item(p, lds, it, tid, lane, wave);
            for (int it = idx; it < 256; it += nB) swa_sample_item(p, lds, it, tid);
            for (int it = idx; it < 512; it += nB) { const int h = it & 3, s = it >> 2;
                dn_scan_item<128, 4, 4>(p, lds, MP + 4 * s, 4, h, 0, p.in[6] + (size_t)(s * 4 + h) * 16384, p.in[5] + (size_t)s * 3 * 1536, p.out + O_SDS + (size_t)(s * 4 + h) * 16384, tid); }
        }
    }
    }
    GSYNC();

    { PH_IDS();
    {
        const bf16_t* oraw = (const bf16_t*)(ws + WS_RA); const float* gn = p.in[15]; bf16_t* yb = (bf16_t*)(ws + WS_YB);
        {
            const int c8 = (lane & 15) * 8, ch = (lane >> 4) * 128 + c8;
            const f32x4 g0 = *(const f32x4*)(gn + c8), g1 = *(const f32x4*)(gn + c8 + 4);
            for (int m = gw; m < MT; m += 2 * NGW) {
                const int mb = (m + NGW < MT) ? (m + NGW) : m;
                const u32x4 oa = *(const u32x4*)(oraw + (size_t)m * 512 + ch), ob = *(const u32x4*)(oraw + (size_t)mb * 512 + ch);
                const f32x4 a0 = (f32x4){bflo(oa.x), bfhi(oa.x), bflo(oa.y), bfhi(oa.y)}, a1 = (f32x4){bflo(oa.z), bfhi(oa.z), bflo(oa.w), bfhi(oa.w)};
                const f32x4 b0 = (f32x4){bflo(ob.x), bfhi(ob.x), bflo(ob.y), bfhi(ob.y)}, b1 = (f32x4){bflo(ob.z), bfhi(ob.z), bflo(ob.w), bfhi(ob.w)};
                const u32x4 za = *(const u32x4*)(Zb + (size_t)m * NZ + ZDZ + ch), zb = *(const u32x4*)(Zb + (size_t)mb * NZ + ZDZ + ch);
                float sa = (a0[0] * a0[0] + a0[1] * a0[1]) + (a0[2] * a0[2] + a0[3] * a0[3]) + (a1[0] * a1[0] + a1[1] * a1[1]) + (a1[2] * a1[2] + a1[3] * a1[3]);
                float sb = (b0[0] * b0[0] + b0[1] * b0[1]) + (b0[2] * b0[2] + b0[3] * b0[3]) + (b1[0] * b1[0] + b1[1] * b1[1]) + (b1[2] * b1[2] + b1[3] * b1[3]);
#pragma unroll
                for (int o = 1; o < 16; o <<= 1) { sa += __shfl_xor(sa, o); sb += __shfl_xor(sb, o); }
                const float ra = __builtin_amdgcn_rsqf(sa * (1.f / 128.f) + EPS), rb = __builtin_amdgcn_rsqf(sb * (1.f / 128.f) + EPS);
                u32x4 wa, wb;
                wa.x = pk2(a0[0] * ra * g0[0] * silu(bflo(za.x)), a0[1] * ra * g0[1] * silu(bfhi(za.x))); wa.y = pk2(a0[2] * ra * g0[2] * silu(bflo(za.y)), a0[3] * ra * g0[3] * silu(bfhi(za.y)));
                wa.z = pk2(a1[0] * ra * g1[0] * silu(bflo(za.z)), a1[1] * ra * g1[1] * silu(bfhi(za.z))); wa.w = pk2(a1[2] * ra * g1[2] * silu(bflo(za.w)), a1[3] * ra * g1[3] * silu(bfhi(za.w)));
                wb.x = pk2(b0[0] * rb * g0[0] * silu(bflo(zb.x)), b0[1] * rb * g0[1] * silu(bfhi(zb.x))); wb.y = pk2(b0[2] * rb * g0[2] * silu(bflo(zb.y)), b0[3] * rb * g0[3] * silu(bfhi(zb.y)));
                wb.z = pk2(b1[0] * rb * g1[0] * silu(bflo(zb.z)), b1[1] * rb * g1[1] * silu(bfhi(zb.z))); wb.w = pk2(b1[2] * rb * g1[2] * silu(bflo(zb.w)), b1[3] * rb * g1[3] * silu(bfhi(zb.w)));
                *(u32x4*)(yb + (size_t)m * 512 + ch) = wa; *(u32x4*)(yb + (size_t)mb * 512 + ch) = wb;
            }
        }
        for (int e = gtid; e < 8 * 3 * 1536; e += GT) { const int cc = e % 1536, r = (e / 1536) % 3, b = e / (3 * 1536);
            p.out[O_PDC + e] = bf2f(Zb[(size_t)(b * 2048 + 2045 + r) * NZ + ZDQ + cc]); }
        for (int e = gtid; e < 128 * 3 * 1536; e += GT) { const int cc = e % 1536, r = (e / 1536) % 3, b = e / (3 * 1536);
            p.out[O_SDC + e] = bf2f(Zb[(size_t)(MP + 4 * b + 1 + r) * NZ + ZDQ + cc]); }
        pg8::Gemm g{(const bf16_t*)(ws + WS_YA), (const bf16_t*)(ws + WS_WA), MP, 1024, 512, 512}; pg8::StaticOrder S; S.init(MP, 1024, G, bid);
        pg8::EpiF8P<FGateA8> E{FGateA8{Zb, (bf16_t*)hres}};
        pg8::gemm_phase<pg8::EpiF8P<FGateA8>, pg8::StaticOrder, true, true>(lds, g, S, E);
        skinny_sample_gemm<512>((const bf16_t*)(ws + WS_YA) + (size_t)MP * 512, (const bf16_t*)(ws + WS_WA), bid, G, lane, wave, FGateA1{Zb, (bf16_t*)hres});
    }
    }
    GSYNC();

    { PH_IDS();
    { pg8::Gemm g{(const bf16_t*)(ws + WS_YB), (const bf16_t*)(ws + WS_WB), MP, 1024, 512, 512}; pg8::StaticOrder S; S.init(MP, 1024, G, bid);
      pg8::EpiF8P<FGateB8> E{FGateB8{Zb, (const bf16_t*)hres, RA}};
      pg8::gemm_phase<pg8::EpiF8P<FGateB8>, pg8::StaticOrder, true, true>(lds, g, S, E);
      skinny_sample_gemm<512>((const bf16_t*)(ws + WS_YB) + (size_t)MP * 512, (const bf16_t*)(ws + WS_WB), bid, G, lane, wave, FGateB1{Zb, (const bf16_t*)hres, RA}); }
    }
    GSYNC();

    { PH_IDS();
    { pg8::Gemm g{RA, (const bf16_t*)(ws + WS_WMO), MP, 1024, 1024, 1024}; pg8::StaticOrder S; S.init(MP, 1024, G, bid);
      pg8::EpiF8P<FResX8> E{FResX8{p.in[0], hres}};
      pg8::gemm_phase<pg8::EpiF8P<FResX8>, pg8::StaticOrder, true, true>(lds, g, S, E);
      skinny_sample_gemm<1024>(RA + (size_t)MP * 1024, (const bf16_t*)(ws + WS_WMO), bid, G, lane, wave, FResX1{p.in[1], hres}); }
    }
    GSYNC();

    { PH_IDS();
    rms_pass<false>(p, p.in[20], gw, NGW, lane);
    }
    GSYNC();

    { PH_IDS();
    { pg8::Gemm g{RA, (const bf16_t*)(ws + WS_WXQ), MT, 512, 1024, 1024}; pg8::StaticOrder S; S.init(MT, 512, G, bid);
      pg8::EpiBf16 E{(bf16_t*)(ws + WS_Z + ZO_HQ), 512};
      pg8::gemm_phase<pg8::EpiBf16, pg8::StaticOrder, true, true>(lds, g, S, E); }
    const int tb0 = (G > 200) ? 168 : 0;
    if (bid >= tb0) {
      LAS float* scr = (LAS float*)(lds + wave * 16384);
      constexpr int J9 = 16 * 176, J10 = 44 * 32;
      for (int it = (bid - tb0) * 8 + wave; it < J9 + J10; it += (G - tb0) * 8) {
          if (it < J9) transpose_item(p.in[26], 5632, 0, 1024, 5632, (bf16_t*)(ws + WS_WUP), 0, scr, it, lane);
          else transpose_item(p.in[28], 1024, 0, 2816, 1024, (bf16_t*)(ws + WS_WDN), 0, scr, it - J9, lane); }
    }
    if (bid >= 136) {
      pg8::Gemm g{(const bf16_t*)(ws + WS_MEMN), (const bf16_t*)(ws + WS_WXKV), 2048, 1024, 1024, 1024}; pg8::StaticOrder S; S.init(2048, 1024, G - 136, bid - 136);
      pg8::EpiF<FMem> E{FMem{p.out + O_PMK, p.out + O_PMV}};
      pg8::gemm_phase<pg8::EpiF<FMem>, pg8::StaticOrder, true, true>(lds, g, S, E); }
    }
    GSYNC();

    { PH_IDS();
    {
        for (int it = bid; it < 256; it += G) { const int xcd = it & 7, slot = it >> 3, bh_ = xcd * 4 + (slot >> 3), qblk = slot & 7, h = bh_ & 3, b = bh_ >> 2;
            xattn_stage(lds, p.out + O_PMK + (size_t)b * 256 * 512, p.out + O_PMV + (size_t)b * 256 * 512, h, tid);
            LBAR();
            xattn_wave<2>(p, lds, b * 2048 + qblk * 256 + 32 * wave, 16, h, lane);
            LBAR(); }
        for (int it = bid; it < 512; it += G) { const int h = it & 3, s = it >> 2;
            xattn_stage(lds, p.in[7] + (size_t)s * 256 * 512, p.in[8] + (size_t)s * 256 * 512, h, tid);
            LBAR();
            if (wave == 0) xattn_wave<1>(p, lds, MP + 4 * s, 4, h, lane);
            LBAR(); }
    }
    }
    GSYNC();

    { PH_IDS();
    { pg8::Gemm g{(const bf16_t*)(ws + WS_Z + ZO_XO), (const bf16_t*)(ws + WS_WXO), MP, 1024, 512, 512}; pg8::StaticOrder S; S.init(MP, 1024, G, bid);
      pg8::EpiF8P<FAcc8> E{FAcc8{hres}};
      pg8::gemm_phase<pg8::EpiF8P<FAcc8>, pg8::StaticOrder, true, true>(lds, g, S, E);
      skinny_sample_gemm<512>((const bf16_t*)(ws + WS_Z + ZO_XO) + (size_t)MP * 512, (const bf16_t*)(ws + WS_WXO), bid, G, lane, wave, FAcc1{hres}); }
    }
    GSYNC();

    { PH_IDS();
    rms_pass<false>(p, p.in[25], gw, NGW, lane);
    }
    GSYNC();

    { PH_IDS();
    { pg8::Gemm g{RA, (const bf16_t*)(ws + WS_WUP), MT, 5632, 1024, 1024}; pg8::StaticOrder S; S.init(MT, 5632, G, bid);
      pg8::EpiBf16 E{(bf16_t*)(ws + WS_Z + ZO_UG), 5632};
      pg8::gemm_phase<pg8::EpiBf16, pg8::StaticOrder, true, true>(lds, g, S, E); }
    GSYNC();
    ffn_gate_chunk(p, 0, MT, gtid, GT);
    GSYNC();
    { pg8::Gemm g{(const bf16_t*)(ws + WS_Z + ZO_UG) + 2816, (const bf16_t*)(ws + WS_WDN), MP, 1024, 2816, 5632, 2816}; pg8::StaticOrder S; S.init(MP, 1024, G, bid);
      pg8::EpiF8P<FAcc8> E{FAcc8{hres}};
      pg8::gemm_phase<pg8::EpiF8P<FAcc8>, pg8::StaticOrder, true, true>(lds, g, S, E); }
    skinny_sample_gemm<2816, FAcc1, 5632>((const bf16_t*)(ws + WS_Z + ZO_UG) + 2816 + (size_t)MP * 5632, (const bf16_t*)(ws + WS_WDN), bid, G, lane, wave, FAcc1{hres});
    }
    GSYNC();

    { PH_IDS();
    rms_pass<true>(p, p.in[29], gw, NGW, lane);
    }
    if (p.ws == nullptr) grid.sync();
}


extern "C" void kernel_launch(void* const* d_in, const int* in_sizes, int n_in, void* d_out, int out_size, void* d_ws, size_t ws_size, hipStream_t stream) {
    static int grid = 0;
    if (grid == 0) {
        if (n_in != 30 || (size_t)out_size != O_END || ws_size < WS_END) { fprintf(stderr, "kernel_launch: unexpected shapes (n_in %d, out %d, ws %zu, need %zu)\n", n_in, out_size, ws_size, (size_t)WS_END); grid = -1; return; }
        int dev = 0, cus = 0, per_cu = 0;
        (void)hipGetDevice(&dev);
        (void)hipDeviceGetAttribute(&cus, hipDeviceAttributeMultiprocessorCount, dev);
        (void)hipFuncSetAttribute((const void*)mega_fwd, hipFuncAttributeMaxDynamicSharedMemorySize, LDS_BYTES);
        if (hipOccupancyMaxActiveBlocksPerMultiprocessor(&per_cu, (const void*)mega_fwd, NTHR, LDS_BYTES) != hipSuccess || per_cu < 1) { fprintf(stderr, "kernel_launch: occupancy query says %d\n", per_cu); per_cu = 1; }
        (void)hipGetLastError();
        grid = cus * 1;
        if (grid <= 0) grid = 256;
    }
    if (grid < 0) return;
    Params p{};
    for (int i = 0; i < 30; ++i) p.in[i] = (const float*)d_in[i];
    p.out = (float*)d_out; p.ws = (unsigned char*)d_ws;
    for (int i = 0; i < 8; ++i) p.inv[i] = pow(500000.0, -(double)i / 8.0);
    (void)hipMemsetAsync((char*)d_ws + WS_CTL, 0, 16384, stream);
    void* args[] = {&p};
    hipError_t e = hipLaunchCooperativeKernel((void*)mega_fwd, dim3(grid), dim3(NTHR), args, LDS_BYTES, stream);
    if (e != hipSuccess) fprintf(stderr, "cooperative launch failed: %s (grid %d)\n", hipGetErrorString(e), grid);
}
```

```cpp
#include <hip/hip_runtime.h>
#include <hip/hip_cooperative_groups.h>
#include <cstdio>
#include <cstdint>
#include <cmath>
namespace cg = cooperative_groups;

namespace pg8 {
#define PG8_LAS __attribute__((address_space(3)))
typedef unsigned short bf16_t;
typedef short bf16x8 __attribute__((ext_vector_type(8)));
typedef float f32x4 __attribute__((ext_vector_type(4)));
typedef unsigned u32x4 __attribute__((ext_vector_type(4)));
constexpr int BM = 256, BK = 64, HALF = 128, HTB = HALF * BK * 2  , STAGE_BYTES = 8 * HTB, NXCD = 8, WGM = 6;

__host__ __device__ __forceinline__ int lds_byte(int r, int c) { const int st = (r >> 4) * 2 + (c >> 5), rr = r & 15, cc = c & 31, ob = rr * 64 + cc * 2; return st * 1024 + (ob ^ (((ob >> 9) & 1) << 5)); }
__host__ __device__ __forceinline__ void stage_rc(int b, int& R, int& C) { const int st = b / 1024, sb = b % 1024, swz = sb ^ (((sb >> 9) & 1) << 5); R = (st >> 1) * 16 + swz / 64; C = (st & 1) * 32 + (swz % 64) / 2; }
__host__ __device__ __forceinline__ int perm32(int rho) { const int n = rho >> 4, i = rho & 15; return 8 * (i >> 2) + 4 * n + (i & 3); }

struct Unit { int pm, pn, k0; };
struct Gemm { const bf16_t* A; const bf16_t* Bt; int M, N, K, ld, ldb; };

struct StaticOrder {
    int nM, nN, nwg, G, c;
    __host__ __device__ void init(int M, int N, int G_, int c_) { nM = M / BM; nN = N / BM; nwg = nM * nN; G = G_; c = c_; }
    __host__ __device__ bool next(int i, Unit& u) const {
        const long L = (long)i * G + c; if (L >= nwg) return false;
        int wgid = (int)L; { const int q = nwg / NXCD, r = nwg % NXCD, xcd = wgid % NXCD, off = wgid / NXCD; wgid = (xcd < r ? xcd * (q + 1) : r * (q + 1) + (xcd - r) * q) + off; }
        const int nig = WGM * nN, gid = wgid / nig, fm = gid * WGM, gsz = (nM - fm) < WGM ? (nM - fm) : WGM;
        u.pm = fm + ((wgid % nig) % gsz); u.pn = (wgid % nig) / gsz; u.k0 = 0; return true;
    }
    __device__ __forceinline__ void a_ready(const Unit&) const {}
    __device__ __forceinline__ void done(const Unit&) const {}
};

template <int NSL, int KLEN, int PM0> struct SliceOrder {
    int c;
    __device__ __forceinline__ bool next(int i, Unit& u) const { if (i != 0 || c >= 8 * NSL) return false; const int u8 = c / NSL, sl = c % NSL;
        u.pm = __builtin_amdgcn_readfirstlane(PM0 + (u8 >> 2)); u.pn = __builtin_amdgcn_readfirstlane(u8 & 3); u.k0 = __builtin_amdgcn_readfirstlane(sl * KLEN); return true; }
    __device__ __forceinline__ void a_ready(const Unit&) const {}
    __device__ __forceinline__ void done(const Unit&) const {}
};
__device__ __forceinline__ unsigned cvt_pk_bf16(float lo, float hi) { unsigned r; asm volatile("v_cvt_pk_bf16_f32 %0, %1, %2" : "=v"(r) : "v"(lo), "v"(hi)); return r; }
typedef unsigned u32x2 __attribute__((ext_vector_type(2)));
struct EpiBf16 {
    static constexpr bool PERM = true, AFTER_DRAIN = false;
    bf16_t* O; int ldc;
    __device__ __forceinline__ void operator()(const f32x4 (&acc)[2][2][4][2], const Unit& u, int wr, int wc, int fr, int fq) const {
        const int row0 = u.pm * BM + wr * 64 + fr; const int col0 = u.pn * BM + wc * 32 + 8 * fq;
#pragma unroll
        for (int ai = 0; ai < 2; ++ai)
#pragma unroll
            for (int m = 0; m < 4; ++m) { bf16_t* rowp = O + (size_t)(row0 + ai * HALF + m * 16) * ldc + col0;
#pragma unroll
                for (int bj = 0; bj < 2; ++bj) { const f32x4 v0 = acc[ai][bj][m][0], v1 = acc[ai][bj][m][1];
                    u32x4 w; w.x = cvt_pk_bf16(v0[0], v0[1]); w.y = cvt_pk_bf16(v0[2], v0[3]); w.z = cvt_pk_bf16(v1[0], v1[1]); w.w = cvt_pk_bf16(v1[2], v1[3]);
                    *(u32x4*)(rowp + bj * HALF) = w; } }
    }
};
template <class F> struct EpiF8 {
    static constexpr bool PERM = true, AFTER_DRAIN = false;
    F f;
    __device__ __forceinline__ void operator()(const f32x4 (&acc)[2][2][4][2], const Unit& u, int wr, int wc, int fr, int fq) const {
        asm volatile("" : "+v"(fr), "+v"(fq));
#pragma unroll
        for (int ai = 0; ai < 2; ++ai)
#pragma unroll
            for (int m = 0; m < 4; ++m) { const int row = u.pm * BM + ai * HALF + wr * 64 + m * 16 + fr;
#pragma unroll
                for (int bj = 0; bj < 2; ++bj) f(row, u.pn * BM + bj * HALF + wc * 32 + 8 * fq, acc[ai][bj][m][0], acc[ai][bj][m][1]); }
    }
};
template <class F> struct EpiF8P {
    static constexpr bool PERM = true, AFTER_DRAIN = false;
    F f;
    __device__ __forceinline__ void operator()(const f32x4 (&acc)[2][2][4][2], const Unit& u, int wr, int wc, int fr, int fq) const {
        asm volatile("" : "+v"(fr), "+v"(fq));
        const int col0 = u.pn * BM + wc * 32 + 8 * fq;
#pragma unroll
        for (int ai = 0; ai < 2; ++ai)
#pragma unroll
        for (int mh = 0; mh < 2; ++mh) {
            const int row0 = u.pm * BM + ai * HALF + wr * 64 + mh * 32 + fr;
            typename F::L ld[2][2];
#pragma unroll
            for (int m = 0; m < 2; ++m)
#pragma unroll
                for (int bj = 0; bj < 2; ++bj) ld[m][bj] = f.load(row0 + m * 16, col0 + bj * HALF);
#pragma unroll
            for (int m = 0; m < 2; ++m)
#pragma unroll
                for (int bj = 0; bj < 2; ++bj) f.apply(row0 + m * 16, col0 + bj * HALF, acc[ai][bj][2 * mh + m][0], acc[ai][bj][2 * mh + m][1], ld[m][bj]);
        }
    }
};
template <class F> struct EpiF {
    static constexpr bool PERM = false, AFTER_DRAIN = false;
    F f;
    __device__ __forceinline__ void operator()(const f32x4 (&acc)[2][2][4][2], const Unit& u, int wr, int wc, int fr, int fq) const {
        asm volatile("" : "+v"(fr), "+v"(fq));
#pragma unroll
        for (int ai = 0; ai < 2; ++ai)
#pragma unroll
            for (int m = 0; m < 4; ++m) { const int row = u.pm * BM + ai * HALF + wr * 64 + m * 16 + fr;
#pragma unroll
                for (int bj = 0; bj < 2; ++bj)
#pragma unroll
                    for (int n = 0; n < 2; ++n) f(row, u.pn * BM + bj * HALF + wc * 32 + n * 16 + 4 * fq, acc[ai][bj][m][n]); }
    }
};
template <class Epi, class Sched, bool ALIGN_EPI = false, bool SP2 = false>
__device__ __forceinline__ void gemm_phase(PG8_LAS unsigned char* lds, const Gemm g, const Sched& S, const Epi& E) {
    const int tid = threadIdx.x, wid = __builtin_amdgcn_readfirstlane(tid >> 6), lane = tid & 63, wr = wid >> 2, wc = wid & 3, fr = lane & 15, fq = lane >> 4;
    const int K = g.ld, KB = g.ldb ? g.ldb : g.ld, nt = g.K / BK;
    unsigned voffA, voffB;
    { int R, C; stage_rc(tid * 16, R, C); const int Rb = Epi::PERM ? ((R & ~31) + perm32(R & 31)) : R;
      voffA = (unsigned)(R * K + C) * 2u; voffB = (unsigned)(Rb * KB + C) * 2u; }
    const size_t rstep64A = (size_t)64 * K * 2, rstep64B = (size_t)64 * KB * 2;
    const size_t kstep = (size_t)(BK * 2);
    const size_t hstepA = (size_t)HALF * K * 2, hstepB = (size_t)HALF * KB * 2;
    const size_t tstepA = 2 * hstepA, tstepB = 2 * hstepB;
    const unsigned ldsw = (unsigned)wid * 1024u;
    const int aoff = lds_byte(wr * 64 + fr, fq * 8), boff = lds_byte(wc * 32 + fr, fq * 8);
#define PG8_SA(b, h) (((b) * 2 + (h)) * HTB)
#define PG8_SB(b, h) ((4 + (b) * 2 + (h)) * HTB)
#define PG8_STAGE(bufoff, gbase, voff, rstep64) do { _Pragma("unroll") for (int _i = 0; _i < 2; ++_i) \
        __builtin_amdgcn_global_load_lds((const unsigned*)((const char*)(gbase) + (size_t)_i * rstep64 + (voff)), (PG8_LAS unsigned*)(lds + (bufoff) + ldsw + _i * 8192), 16, 0, 0); } while (0)
#define PG8_LDA(dst, b, h) do { _Pragma("unroll") for (int m = 0; m < 4; ++m) _Pragma("unroll") for (int k = 0; k < 2; ++k) dst[m][k] = *(const PG8_LAS bf16x8*)(lds + PG8_SA(b, h) + aoff + m * 2048 + k * 1024); } while (0)
#define PG8_LDB(dst, b, h) do { _Pragma("unroll") for (int n = 0; n < 2; ++n) _Pragma("unroll") for (int k = 0; k < 2; ++k) dst[n][k] = *(const PG8_LAS bf16x8*)(lds + PG8_SB(b, h) + boff + n * 2048 + k * 1024); } while (0)
#define PG8_MMA(ai, bj, At, Bt) do { __builtin_amdgcn_s_setprio(1); _Pragma("unroll") for (int m = 0; m < 4; ++m) _Pragma("unroll") for (int n = 0; n < 2; ++n) _Pragma("unroll") for (int k = 0; k < 2; ++k) \
        acc[ai][bj][m][n] = __builtin_amdgcn_mfma_f32_16x16x32_bf16(Bt[n][k], At[m][k], acc[ai][bj][m][n], 0, 0, 0); __builtin_amdgcn_s_setprio(0); } while (0)
#define PG8_WAIT_V(n) asm volatile("s_waitcnt vmcnt(" #n ")" ::: "memory")
#define PG8_WAIT_L(n) asm volatile("s_waitcnt lgkmcnt(" #n ")" ::: "memory")
#define PG8_BAR __builtin_amdgcn_s_barrier()
#define PG8_SCHED __builtin_amdgcn_sched_barrier(0)
    Unit cur, nxt; int ui = 0;
    if (!S.next(0, cur)) return;
    f32x4 acc[2][2][4][2];
#pragma unroll
    for (int a = 0; a < 2; ++a)
#pragma unroll
        for (int b = 0; b < 2; ++b)
#pragma unroll
            for (int m = 0; m < 4; ++m)
#pragma unroll
                for (int n = 0; n < 2; ++n) acc[a][b][m][n] = (f32x4){0.f, 0.f, 0.f, 0.f};
    bf16x8 At[4][2], B0[2][2], B1[2][2];
    const char* cA = (const char*)g.A + (size_t)cur.pm * tstepA + (size_t)cur.k0 * 2; const char* cB = (const char*)g.Bt + (size_t)cur.pn * tstepB + (size_t)cur.k0 * 2;
    S.a_ready(cur);
    if constexpr (SP2) {
        PG8_STAGE(PG8_SB(0, 0), cB, voffB, rstep64B); PG8_STAGE(PG8_SB(0, 1), cB + hstepB, voffB, rstep64B); PG8_STAGE(PG8_SA(0, 0), cA, voffA, rstep64A); PG8_STAGE(PG8_SA(0, 1), cA + hstepA, voffA, rstep64A);
        if (wr == 1) PG8_BAR;
        PG8_WAIT_V(2); PG8_BAR;
        PG8_STAGE(PG8_SB(1, 0), cB + kstep, voffB, rstep64B); PG8_STAGE(PG8_SA(1, 0), cA + kstep, voffA, rstep64A); PG8_STAGE(PG8_SB(1, 1), cB + hstepB + kstep, voffB, rstep64B);
        PG8_WAIT_V(6); PG8_BAR;
    } else {
        PG8_STAGE(PG8_SB(0, 0), cB, voffB, rstep64B); PG8_STAGE(PG8_SA(0, 0), cA, voffA, rstep64A); PG8_STAGE(PG8_SB(0, 1), cB + hstepB, voffB, rstep64B); PG8_STAGE(PG8_SA(0, 1), cA + hstepA, voffA, rstep64A);
        if (wr == 1) PG8_BAR;
        PG8_WAIT_V(4); PG8_BAR;
        PG8_STAGE(PG8_SB(1, 0), cB + kstep, voffB, rstep64B); PG8_STAGE(PG8_SA(1, 0), cA + kstep, voffA, rstep64A); PG8_STAGE(PG8_SB(1, 1), cB + hstepB + kstep, voffB, rstep64B);
        PG8_WAIT_V(6); PG8_BAR;
    }
    for (;;) {
        const bool has_next = S.next(ui + 1, nxt);
        const char* nA = has_next ? (const char*)g.A + (size_t)nxt.pm * tstepA + (size_t)nxt.k0 * 2 : cA; const char* nB = has_next ? (const char*)g.Bt + (size_t)nxt.pn * tstepB + (size_t)nxt.k0 * 2 : cB;
        for (int t = 0; t < nt; t += 2) {
            const bool last = (t == nt - 2);
            const char* a1 = cA + (size_t)(t + 1) * kstep;
            const char* a2 = last ? nA : cA + (size_t)(t + 2) * kstep; const char* b2 = last ? nB : cB + (size_t)(t + 2) * kstep;
            const char* a3 = a2 + kstep; const char* b3 = b2 + kstep;
            if (last && has_next) S.a_ready(nxt);
            if constexpr (SP2) {
            PG8_LDB(B0, 0, 0); PG8_LDB(B1, 0, 1); PG8_SCHED; PG8_LDA(At, 0, 0); PG8_STAGE(PG8_SA(1, 1), a1 + hstepA, voffA, rstep64A);
            PG8_WAIT_V(8); PG8_WAIT_L(0); PG8_BAR; PG8_MMA(0, 0, At, B0); PG8_MMA(0, 1, At, B1); PG8_BAR; PG8_SCHED;
            PG8_LDA(At, 0, 1); PG8_STAGE(PG8_SB(0, 0), b2, voffB, rstep64B); PG8_STAGE(PG8_SB(0, 1), b2 + hstepB, voffB, rstep64B); PG8_STAGE(PG8_SA(0, 0), a2, voffA, rstep64A);
            PG8_WAIT_V(8); PG8_WAIT_L(0); PG8_BAR; PG8_MMA(1, 0, At, B0); PG8_MMA(1, 1, At, B1); PG8_BAR; PG8_SCHED;
            PG8_LDB(B0, 1, 0); PG8_LDB(B1, 1, 1); PG8_SCHED; PG8_LDA(At, 1, 0); PG8_STAGE(PG8_SA(0, 1), a2 + hstepA, voffA, rstep64A);
            PG8_WAIT_V(8); PG8_WAIT_L(0); PG8_BAR; PG8_MMA(0, 0, At, B0); PG8_MMA(0, 1, At, B1); PG8_BAR; PG8_SCHED;
            PG8_LDA(At, 1, 1); PG8_STAGE(PG8_SB(1, 0), b3, voffB, rstep64B); PG8_STAGE(PG8_SB(1, 1), b3 + hstepB, voffB, rstep64B); PG8_STAGE(PG8_SA(1, 0), a3, voffA, rstep64A);
            PG8_WAIT_V(8); PG8_WAIT_L(0); PG8_BAR; PG8_MMA(1, 0, At, B0); PG8_MMA(1, 1, At, B1); PG8_BAR; PG8_SCHED;
            } else {
            PG8_LDB(B0, 0, 0); PG8_SCHED; PG8_LDA(At, 0, 0); PG8_STAGE(PG8_SA(1, 1), a1 + hstepA, voffA, rstep64A);
            PG8_WAIT_L(8); PG8_BAR; PG8_WAIT_L(0); PG8_MMA(0, 0, At, B0); PG8_BAR; PG8_SCHED;
            PG8_LDB(B1, 0, 1); PG8_STAGE(PG8_SB(0, 0), b2, voffB, rstep64B);
            PG8_BAR; PG8_WAIT_L(0); PG8_MMA(0, 1, At, B1); PG8_BAR;
            PG8_LDA(At, 0, 1); PG8_STAGE(PG8_SA(0, 0), a2, voffA, rstep64A);
            PG8_BAR; PG8_WAIT_L(0); PG8_MMA(1, 0, At, B0); PG8_BAR; PG8_SCHED;
            PG8_STAGE(PG8_SB(0, 1), b2 + hstepB, voffB, rstep64B);
            PG8_WAIT_V(6); PG8_BAR; PG8_MMA(1, 1, At, B1); PG8_BAR;
            PG8_LDB(B0, 1, 0); PG8_SCHED; PG8_LDA(At, 1, 0); PG8_STAGE(PG8_SA(0, 1), a2 + hstepA, voffA, rstep64A);
            PG8_WAIT_L(8); PG8_BAR; PG8_WAIT_L(0); PG8_MMA(0, 0, At, B0); PG8_BAR; PG8_SCHED;
            PG8_LDB(B1, 1, 1); PG8_STAGE(PG8_SB(1, 0), b3, voffB, rstep64B);
            PG8_BAR; PG8_WAIT_L(0); PG8_MMA(0, 1, At, B1); PG8_BAR;
            PG8_LDA(At, 1, 1); PG8_STAGE(PG8_SA(1, 0), a3, voffA, rstep64A);
            PG8_BAR; PG8_WAIT_L(0); PG8_MMA(1, 0, At, B0); PG8_BAR; PG8_SCHED;
            PG8_STAGE(PG8_SB(1, 1), b3 + hstepB, voffB, rstep64B);
            PG8_WAIT_V(6); PG8_BAR; PG8_MMA(1, 1, At, B1); PG8_BAR;
            }
        }
        if constexpr (ALIGN_EPI) { if (wr == 0) PG8_BAR; }
        if constexpr (!Epi::AFTER_DRAIN) { E(acc, cur, wr, wc, fr, fq); S.done(cur); }
        if (!has_next) break;
#pragma unroll
        for (int a = 0; a < 2; ++a)
#pragma unroll
            for (int b = 0; b < 2; ++b)
#pragma unroll
                for (int m = 0; m < 4; ++m)
#pragma unroll
                    for (int n = 0; n < 2; ++n) acc[a][b][m][n] = (f32x4){0.f, 0.f, 0.f, 0.f};
        cur = nxt; cA = nA; cB = nB; ++ui;
        if constexpr (ALIGN_EPI) { if (wr == 1) PG8_BAR; }
    }
    PG8_WAIT_V(0);
    if constexpr (!ALIGN_EPI) { if (wr == 0) PG8_BAR; }
    PG8_BAR;
    if constexpr (Epi::AFTER_DRAIN) { E.fused(acc, cur, wr, wc, fr, fq, lds, wid, lane); S.done(cur); }
#undef PG8_SA
#undef PG8_SB
#undef PG8_STAGE
#undef PG8_LDA
#undef PG8_LDB
#undef PG8_MMA
#undef PG8_WAIT_V
#undef PG8_WAIT_L
#undef PG8_BAR
#undef PG8_SCHED
}
}

#define LAS __attribute__((address_space(3)))
typedef unsigned short bf16_t;
typedef short bf16x8 __attribute__((ext_vector_type(8)));
typedef short s16x4 __attribute__((ext_vector_type(4)));
typedef float f32x4 __attribute__((ext_vector_type(4)));
typedef float f32x2 __attribute__((ext_vector_type(2)));
typedef unsigned u32x4 __attribute__((ext_vector_type(4)));
typedef unsigned u32x2 __attribute__((ext_vector_type(2)));

constexpr int MP = 16384, MS = 512, MT = MP + MS;
constexpr int NZ = 4864;
constexpr int ZK = 512, ZV = 640, ZDQ = 768, ZDZ = 2304, ZGA = 2816, ZGB = 3840;
constexpr int NTHR = 512;
constexpr int LDS_BYTES = 163840;
constexpr float EPS = 1e-6f;

constexpr size_t O_Y = 0;
constexpr size_t O_PWK = (size_t)MT * 1024;
constexpr size_t O_PWV = O_PWK + 131072;
constexpr size_t O_PDC = O_PWV + 131072;
constexpr size_t O_PDS = O_PDC + 36864;
constexpr size_t O_PMK = O_PDS + 524288;
constexpr size_t O_PMV = O_PMK + 1048576;
constexpr size_t O_PFC = O_PMV + 1048576;
constexpr size_t O_SWK = O_PFC + 45056;
constexpr size_t O_SWV = O_SWK + 2097152;
constexpr size_t O_SDC = O_SWV + 2097152;
constexpr size_t O_SDS = O_SDC + 589824;
constexpr size_t O_SFC = O_SDS + 8388608;
constexpr size_t O_END = O_SFC + 720896;

constexpr size_t WS_WIN = 0;
constexpr size_t WS_WA = WS_WIN + (size_t)4864 * 1024 * 2;
constexpr size_t WS_WB = WS_WA + (size_t)1024 * 512 * 2;
constexpr size_t WS_WMO = WS_WB + (size_t)1024 * 512 * 2;
constexpr size_t WS_WXQ = WS_WMO + (size_t)1024 * 1024 * 2;
constexpr size_t WS_WXKV = WS_WXQ + (size_t)512 * 1024 * 2;
constexpr size_t WS_WXO = WS_WXKV + (size_t)1024 * 1024 * 2;
constexpr size_t WS_WUP = WS_WXO + (size_t)1024 * 512 * 2;
constexpr size_t WS_WDN = WS_WUP + (size_t)5632 * 1024 * 2;
constexpr size_t WS_RA = WS_WDN + (size_t)1024 * 2816 * 2;
constexpr size_t WS_Z = WS_RA + (size_t)MT * 1024 * 2;
constexpr size_t WS_YA = WS_Z + (size_t)MT * NZ * 2;
constexpr size_t WS_YB = WS_YA + (size_t)MT * 512 * 2;
constexpr size_t WS_MEMN = WS_YB + (size_t)MT * 512 * 2;
constexpr size_t WS_GB = WS_MEMN + (size_t)2048 * 1024 * 2;
constexpr size_t WS_ROPE = WS_GB + (size_t)MT * 8 * 4;
constexpr size_t WS_GLAST = WS_ROPE + (size_t)2052 * 16 * 4;
constexpr size_t WS_CTL = WS_GLAST + 4096;
constexpr size_t WS_END = WS_CTL + 16384;
constexpr size_t ZO_HQ = 0, ZO_XO = (size_t)MT * 512 * 2;
constexpr size_t ZO_UG = 0;
static_assert(ZO_UG + (size_t)MT * 5632 * 2 <= (size_t)MT * NZ * 2 + 2 * (size_t)MT * 512 * 2 && WS_YA == WS_Z + (size_t)MT * NZ * 2 && WS_YB == WS_YA + (size_t)MT * 512 * 2, "FFN overlay fits in Z|YA|YB");

struct Params { const float* in[30]; float* out; unsigned char* ws; double inv[8]; };

__device__ __forceinline__ unsigned f2bf(float f) { unsigned r; asm("v_cvt_pk_bf16_f32 %0, %1, %1" : "=v"(r) : "v"(f)); return r & 0xffffu; }
__device__ __forceinline__ unsigned pk2(float lo, float hi) { unsigned r; asm("v_cvt_pk_bf16_f32 %0, %1, %2" : "=v"(r) : "v"(lo), "v"(hi)); return r; }
__device__ __forceinline__ float bf2f(unsigned short b) { return __builtin_bit_cast(float, (unsigned)b << 16); }
__device__ __forceinline__ float bflo(unsigned w) { return __builtin_bit_cast(float, w << 16); }
__device__ __forceinline__ float bfhi(unsigned w) { return __builtin_bit_cast(float, w & 0xffff0000u); }
__device__ __forceinline__ float sigm(float x) { return __builtin_amdgcn_rcpf(1.f + __expf(-x)); }
__device__ __forceinline__ float silu(float x) { return x * __builtin_amdgcn_rcpf(1.f + __expf(-x)); }
__device__ __forceinline__ float wave_sum(float v) {
#pragma unroll
    for (int o = 1; o < 64; o <<= 1) v += __shfl_xor(v, o);
    return v;
}

#define LBAR() do { asm volatile("s_waitcnt lgkmcnt(0)" ::: "memory"); __builtin_amdgcn_s_barrier(); asm volatile("" ::: "memory"); } while (0)
struct FMem { float* pk; float* pv;
    __device__ __forceinline__ void operator()(int row, int col, const f32x4& v) const {
        float* d = (col < 512) ? (pk + (size_t)row * 512 + col) : (pv + (size_t)row * 512 + (col - 512)); *(f32x4*)d = v; } };
struct FGateA { const bf16_t* Z; float* t1;
    __device__ __forceinline__ void operator()(int row, int col, const f32x4& v) const {
        const u32x2 g = *(const u32x2*)(Z + (size_t)row * NZ + ZGA + col);
        f32x4 o; o[0] = sigm(bflo(g.x)) * v[0]; o[1] = sigm(bfhi(g.x)) * v[1]; o[2] = sigm(bflo(g.y)) * v[2]; o[3] = sigm(bfhi(g.y)) * v[3];
        *(f32x4*)(t1 + (size_t)row * 1024 + col) = o; } };
struct FGateB { const bf16_t* Z; const float* t1; bf16_t* mix;
    __device__ __forceinline__ void operator()(int row, int col, const f32x4& v) const {
        const u32x2 g = *(const u32x2*)(Z + (size_t)row * NZ + ZGB + col);
        const f32x4 t = *(const f32x4*)(t1 + (size_t)row * 1024 + col);
        u32x2 w; w.x = pk2(t[0] + sigm(bflo(g.x)) * v[0], t[1] + sigm(bfhi(g.x)) * v[1]); w.y = pk2(t[2] + sigm(bflo(g.y)) * v[2], t[3] + sigm(bfhi(g.y)) * v[3]);
        *(u32x2*)(mix + (size_t)row * 1024 + col) = w; } };
struct FResX { const float* xp; const float* xs; float* h;
    __device__ __forceinline__ void operator()(int row, int col, const f32x4& v) const {
        const float* x = (row < MP) ? (xp + (size_t)row * 1024 + col) : (xs + (size_t)(row - MP) * 1024 + col);
        *(f32x4*)(h + (size_t)row * 1024 + col) = *(const f32x4*)x + v; } };
struct FAcc { float* h; int row_off;
    __device__ __forceinline__ void operator()(int row, int col, const f32x4& v) const {
        float* d = h + (size_t)(row + row_off) * 1024 + col; *(f32x4*)d = *(const f32x4*)d + v; } };

struct FGateA8 { const bf16_t* Z; bf16_t* t1;
    struct L { u32x4 g; };
    __device__ __forceinline__ L load(int row, int col) const { L l; l.g = *(const u32x4*)(Z + (size_t)row * NZ + ZGA + col); return l; }
    __device__ __forceinline__ void apply(int row, int col, const f32x4& v0, const f32x4& v1, const L& l) const {
        const u32x4 g = l.g;
        u32x4 w; w.x = pk2(sigm(bflo(g.x)) * v0[0], sigm(bfhi(g.x)) * v0[1]); w.y = pk2(sigm(bflo(g.y)) * v0[2], sigm(bfhi(g.y)) * v0[3]);
        w.z = pk2(sigm(bflo(g.z)) * v1[0], sigm(bfhi(g.z)) * v1[1]); w.w = pk2(sigm(bflo(g.w)) * v1[2], sigm(bfhi(g.w)) * v1[3]);
        *(u32x4*)(t1 + (size_t)row * 1024 + col) = w; } };
struct FGateB8 { const bf16_t* Z; const bf16_t* t1; bf16_t* mix;
    struct L { u32x4 g, t; };
    __device__ __forceinline__ L load(int row, int col) const { L l; l.g = *(const u32x4*)(Z + (size_t)row * NZ + ZGB + col); l.t = *(const u32x4*)(t1 + (size_t)row * 1024 + col); return l; }
    __device__ __forceinline__ void apply(int row, int col, const f32x4& v0, const f32x4& v1, const L& l) const {
        const u32x4 g = l.g, tw = l.t;
        u32x4 w; w.x = pk2(bflo(tw.x) + sigm(bflo(g.x)) * v0[0], bfhi(tw.x) + sigm(bfhi(g.x)) * v0[1]); w.y = pk2(bflo(tw.y) + sigm(bflo(g.y)) * v0[2], bfhi(tw.y) + sigm(bfhi(g.y)) * v0[3]);
        w.z = pk2(bflo(tw.z) + sigm(bflo(g.z)) * v1[0], bfhi(tw.z) + sigm(bfhi(g.z)) * v1[1]); w.w = pk2(bflo(tw.w) + sigm(bflo(g.w)) * v1[2], bfhi(tw.w) + sigm(bfhi(g.w)) * v1[3]);
        *(u32x4*)(mix + (size_t)row * 1024 + col) = w; } };
struct FResX8 { const float* xp; float* h;
    struct L { f32x4 a, b; };
    __device__ __forceinline__ L load(int row, int col) const { const float* x = xp + (size_t)row * 1024 + col; L l; l.a = *(const f32x4*)x; l.b = *(const f32x4*)(x + 4); return l; }
    __device__ __forceinline__ void apply(int row, int col, const f32x4& v0, const f32x4& v1, const L& l) const {
        float* d = h + (size_t)row * 1024 + col; *(f32x4*)d = l.a + v0; *(f32x4*)(d + 4) = l.b + v1; } };
struct FAcc8 { float* h;
    struct L { f32x4 a, b; };
    __device__ __forceinline__ L load(int row, int col) const { const float* x = h + (size_t)row * 1024 + col; L l; l.a = *(const f32x4*)x; l.b = *(const f32x4*)(x + 4); return l; }
    __device__ __forceinline__ void apply(int row, int col, const f32x4& v0, const f32x4& v1, const L& l) const {
        float* d = h + (size_t)row * 1024 + col; *(f32x4*)d = l.a + v0; *(f32x4*)(d + 4) = l.b + v1; } };
struct FAccAtomic { float* h;
    __device__ __forceinline__ void operator()(int row, int col, const f32x4& v) const {
        float* d = h + (size_t)row * 1024 + col;
#pragma unroll
        for (int e = 0; e < 4; ++e) (void)__hip_atomic_fetch_add(d + e, v[e], __ATOMIC_RELAXED, __HIP_MEMORY_SCOPE_AGENT); } };

__device__ __forceinline__ void transpose_item(const float* __restrict__ W, int ldw, int col0, int K, int ncols, bf16_t* WT, int row_off, LAS float* scr, int item, int lane) {
    const int nblk = ncols / 32, kb = item / nblk, nb = item % nblk, k0 = 64 * kb, n0 = 32 * nb;
#pragma unroll
    for (int i = 0; i < 32; ++i) { const int kk = 2 * i + (lane >> 5); scr[kk * 33 + (lane & 31)] = W[(size_t)(k0 + kk) * ldw + col0 + n0 + (lane & 31)]; }
    asm volatile("s_waitcnt lgkmcnt(0)" ::: "memory");
    const int c = lane & 7;
#pragma unroll
    for (int j = 0; j < 4; ++j) { const int n = (lane >> 3) + 8 * j; const LAS float* s = scr + (8 * c) * 33 + n;
        u32x4 o; o.x = pk2(s[0 * 33], s[1 * 33]); o.y = pk2(s[2 * 33], s[3 * 33]); o.z = pk2(s[4 * 33], s[5 * 33]); o.w = pk2(s[6 * 33], s[7 * 33]);
        *(u32x4*)(WT + (size_t)(row_off + n0 + n) * K + k0 + 8 * c) = o; }
    asm volatile("s_waitcnt lgkmcnt(0)" ::: "memory");
}

template <bool DAB>
__device__ __forceinline__ void norm_row_bf16(const float* xrow, const float* g, bf16_t* orow, int lane, const LAS float* sW, float* gb_out, const float* alog, const float* dtb) {
    f32x4 v[4]; float ss = 0.f;
#pragma unroll
    for (int j = 0; j < 4; ++j) { v[j] = ((const f32x4*)xrow)[lane + 64 * j]; ss += (v[j][0] * v[j][0] + v[j][1] * v[j][1]) + (v[j][2] * v[j][2] + v[j][3] * v[j][3]); }
    const float rs = __builtin_amdgcn_rsqf(wave_sum(ss) * (1.f / 1024.f) + EPS);
#pragma unroll
    for (int j = 0; j < 4; ++j) { const f32x4 gg = ((const f32x4*)g)[lane + 64 * j]; v[j] = v[j] * rs * gg;
        u32x2 w; w.x = pk2(v[j][0], v[j][1]); w.y = pk2(v[j][2], v[j][3]); ((u32x2*)orow)[lane + 64 * j] = w; }
    if constexpr (DAB) {
        float acc[8];
#pragma unroll
        for (int i = 0; i < 8; ++i) acc[i] = 0.f;
#pragma unroll
        for (int j = 0; j < 4; ++j)
#pragma unroll
            for (int e = 0; e < 4; ++e) { const int k = 4 * lane + 256 * j + e; const f32x4 w0 = *(const LAS f32x4*)(sW + k * 8), w1 = *(const LAS f32x4*)(sW + k * 8 + 4); const float x = v[j][e];
                acc[0] += x * w0[0]; acc[1] += x * w0[1]; acc[2] += x * w0[2]; acc[3] += x * w0[3]; acc[4] += x * w1[0]; acc[5] += x * w1[1]; acc[6] += x * w1[2]; acc[7] += x * w1[3]; }
#pragma unroll
        for (int i = 0; i < 8; ++i) acc[i] = wave_sum(acc[i]);
        if (lane == 0) {
            f32x4 o0, o1;
#pragma unroll
            for (int i = 0; i < 4; ++i) { const float x = acc[i] + dtb[i]; const float sp = (x > 20.f) ? x : log1pf(expf(x)); o0[i] = -expf(alog[i]) * sp; o1[i] = 1.f / (1.f + expf(-acc[4 + i])); }
            *(f32x4*)gb_out = o0; *(f32x4*)(gb_out + 4) = o1;
        }
    }
}

__device__ __forceinline__ void p0_prologue(const Params& p, LAS unsigned char* lds, int tid, int lane, int wave, int G) {
    unsigned char* ws = p.ws;
    LAS float* scr = (LAS float*)(lds + wave * 16384);
    const int gw = blockIdx.x * 8 + wave, NGW = G * 8;
    constexpr int I1 = 16 * 88, I2 = 16 * 64, I3 = 8 * 32, I5 = 16 * 32, I6 = 16 * 16, I9 = 16 * 176, I10 = 44 * 32;
    constexpr int NITEMS = I1 + I2 + I3 + I3;
    for (int it = gw; it < NITEMS; it += NGW) {
        int r = it;
        if (r < I1) { transpose_item(p.in[11], 4872, 0, 1024, 2816, (bf16_t*)(ws + WS_WIN), 0, scr, r, lane); continue; } r -= I1;
        if (r < I2) { transpose_item(p.in[11], 4872, 2824, 1024, 2048, (bf16_t*)(ws + WS_WIN), 2816, scr, r, lane); continue; } r -= I2;
        if (r < I3) { transpose_item(p.in[17], 1024, 0, 512, 1024, (bf16_t*)(ws + WS_WA), 0, scr, r, lane); continue; } r -= I3;
        transpose_item(p.in[18], 1024, 0, 512, 1024, (bf16_t*)(ws + WS_WB), 0, scr, r, lane);
    }
    (void)I5; (void)I6;
    {
        float* tab = (float*)(ws + WS_ROPE);
        for (int idx = blockIdx.x * NTHR + tid; idx < 2052 * 8; idx += G * NTHR) {
            const int pi = idx >> 3, i = idx & 7; const int pos = pi < 2048 ? pi : 16384 + (pi - 2048);
            double t = (double)pos * p.inv[i] * 0.15915494309189535; t -= __builtin_floor(t);
            const float r = (float)t;
            tab[idx * 2] = __builtin_amdgcn_cosf(r); tab[idx * 2 + 1] = __builtin_amdgcn_sinf(r);
        }
    }
    __syncthreads();
    LAS float* sW = (LAS float*)lds;
    for (int e = tid; e < 8192; e += NTHR) sW[e] = p.in[11][(size_t)(e >> 3) * 4872 + 2816 + (e & 7)];
    __syncthreads();
    for (int m = gw; m < MT; m += 2 * NGW) {
        const int mb = (m + NGW < MT) ? (m + NGW) : m;
        const float* xa = (m < MP) ? p.in[0] + (size_t)m * 1024 : p.in[1] + (size_t)(m - MP) * 1024;
        const float* xb = (mb < MP) ? p.in[0] + (size_t)mb * 1024 : p.in[1] + (size_t)(mb - MP) * 1024;
        f32x4 va[4], vb[4]; float sa = 0.f, sb = 0.f;
#pragma unroll
        for (int j = 0; j < 4; ++j) { va[j] = ((const f32x4*)xa)[lane + 64 * j]; vb[j] = ((const f32x4*)xb)[lane + 64 * j]; }
#pragma unroll
        for (int j = 0; j < 4; ++j) { sa += (va[j][0] * va[j][0] + va[j][1] * va[j][1]) + (va[j][2] * va[j][2] + va[j][3] * va[j][3]); sb += (vb[j][0] * vb[j][0] + vb[j][1] * vb[j][1]) + (vb[j][2] * vb[j][2] + vb[j][3] * vb[j][3]); }
#pragma unroll
        for (int o = 1; o < 64; o <<= 1) { sa += __shfl_xor(sa, o); sb += __shfl_xor(sb, o); }
        const float ra = __builtin_amdgcn_rsqf(sa * (1.f / 1024.f) + EPS), rb = __builtin_amdgcn_rsqf(sb * (1.f / 1024.f) + EPS);
        float acc[16];
#pragma unroll
        for (int i = 0; i < 16; ++i) acc[i] = 0.f;
        bf16_t* oa = (bf16_t*)(ws + WS_RA) + (size_t)m * 1024; bf16_t* ob = (bf16_t*)(ws + WS_RA) + (size_t)mb * 1024;
#pragma unroll
        for (int j = 0; j < 4; ++j) { const f32x4 gg = ((const f32x4*)p.in[10])[lane + 64 * j]; va[j] = va[j] * ra * gg; vb[j] = vb[j] * rb * gg;
            u32x2 w; w.x = pk2(va[j][0], va[j][1]); w.y = pk2(va[j][2], va[j][3]); ((u32x2*)oa)[lane + 64 * j] = w;
            u32x2 w2; w2.x = pk2(vb[j][0], vb[j][1]); w2.y = pk2(vb[j][2], vb[j][3]); ((u32x2*)ob)[lane + 64 * j] = w2;
#pragma unroll
            for (int e = 0; e < 4; ++e) { const int k = 4 * lane + 256 * j + e; const f32x4 w0 = *(const LAS f32x4*)(sW + k * 8), w1 = *(const LAS f32x4*)(sW + k * 8 + 4); const float xA = va[j][e], xB = vb[j][e];
                acc[0] += xA * w0[0]; acc[1] += xA * w0[1]; acc[2] += xA * w0[2]; acc[3] += xA * w0[3]; acc[4] += xA * w1[0]; acc[5] += xA * w1[1]; acc[6] += xA * w1[2]; acc[7] += xA * w1[3];
                acc[8] += xB * w0[0]; acc[9] += xB * w0[1]; acc[10] += xB * w0[2]; acc[11] += xB * w0[3]; acc[12] += xB * w1[0]; acc[13] += xB * w1[1]; acc[14] += xB * w1[2]; acc[15] += xB * w1[3]; } }
#pragma unroll
        for (int o = 1; o < 64; o <<= 1) {
#pragma unroll
            for (int i = 0; i < 16; ++i) acc[i] += __shfl_xor(acc[i], o); }
        if (lane < 2) { const int r = lane ? mb : m; const float* a8 = acc;
            f32x4 o0, o1;
#pragma unroll
            for (int i = 0; i < 4; ++i) { const float da = lane ? a8[8 + i] : a8[i], db = lane ? a8[12 + i] : a8[4 + i];
                const float x = da + p.in[14][i]; const float sp = (x > 20.f) ? x : log1pf(expf(x)); o0[i] = -expf(p.in[13][i]) * sp; o1[i] = 1.f / (1.f + expf(-db)); }
            float* gbo = (float*)(ws + WS_GB) + (size_t)r * 8; *(f32x4*)gbo = o0; *(f32x4*)(gbo + 4) = o1; }
    }
    for (int m = gw; m < 2048; m += NGW)
        norm_row_bf16<false>(p.in[2] + (size_t)m * 1024, p.in[21], (bf16_t*)(ws + WS_MEMN) + (size_t)m * 1024, lane, sW, nullptr, nullptr, nullptr);
}

#define MFMA16(a, b, c) __builtin_amdgcn_mfma_f32_16x16x32_bf16(a, b, c, 0, 0, 0)
__device__ __forceinline__ bf16x8 pack_p(const f32x4& a, const f32x4& b) {
    u32x4 w; w.x = pk2(a[0], a[1]); w.y = pk2(a[2], a[3]); w.z = pk2(b[0], b[1]); w.w = pk2(b[2], b[3]); return __builtin_bit_cast(bf16x8, w);
}

__device__ __forceinline__ void swa_prompt_item(const Params& p, LAS unsigned char* lds, int item, int tid, int lane, int wave) {
    const int kvh = item & 1, blk = (item >> 1) & 15, b = item >> 5;
    const bf16_t* Z = (const bf16_t*)(p.ws + WS_Z);
    const float* tab = (const float*)(p.ws + WS_ROPE);
    LAS bf16_t* sK = (LAS bf16_t*)lds;
    LAS bf16_t* sVt = (LAS bf16_t*)(lds + 36864);
    {
        const int key = tid >> 1, half = tid & 1;
        const int pos = blk * 128 - 128 + key;
        u32x4 k4[4], v4[4];
        if (pos >= 0) { const bf16_t* zr = Z + (size_t)(b * 2048 + pos) * NZ;
#pragma unroll
            for (int i = 0; i < 4; ++i) { k4[i] = *(const u32x4*)(zr + ZK + kvh * 64 + 32 * half + 8 * i); v4[i] = *(const u32x4*)(zr + ZV + kvh * 64 + 32 * half + 8 * i); }
            if (half == 0) {
                const f32x4* cs = (const f32x4*)(tab + (size_t)pos * 16);
                u32x4 r1, r2;
#pragma unroll
                for (int w = 0; w < 4; ++w) { const f32x4 c4 = cs[w];
                    const float a0 = bflo(k4[0][w]), a1 = bfhi(k4[0][w]), b0 = bflo(k4[1][w]), b1 = bfhi(k4[1][w]);
                    r1[w] = pk2(a0 * c4[0] - b0 * c4[1], a1 * c4[2] - b1 * c4[3]);
                    r2[w] = pk2(b0 * c4[0] + a0 * c4[1], b1 * c4[2] + a1 * c4[3]); }
                k4[0] = r1; k4[1] = r2;
            }
        } else {
#pragma unroll
            for (int i = 0; i < 4; ++i) { k4[i] = (u32x4){0u, 0u, 0u, 0u}; v4[i] = (u32x4){0u, 0u, 0u, 0u}; }
        }
#pragma unroll
        for (int i = 0; i < 4; ++i) *(LAS u32x4*)(sK + key * 72 + 32 * half + 8 * i) = k4[i];
#pragma unroll
        for (int i = 0; i < 4; ++i)
#pragma unroll
            for (int w = 0; w < 4; ++w) { sVt[(32 * half + 8 * i + 2 * w) * 264 + key] = (bf16_t)(v4[i][w] & 0xffffu); sVt[(32 * half + 8 * i + 2 * w + 1) * 264 + key] = (bf16_t)(v4[i][w] >> 16); }
        if (blk == 15 && key >= 128) {
            float* ok = p.out + O_PWK + ((size_t)(b * 128 + key - 128) * 2 + kvh) * 64 + 32 * half;
            float* ov = p.out + O_PWV + ((size_t)(b * 128 + key - 128) * 2 + kvh) * 64 + 32 * half;
#pragma unroll
            for (int i = 0; i < 4; ++i) {
                *(f32x4*)(ok + 8 * i) = (f32x4){bflo(k4[i][0]), bfhi(k4[i][0]), bflo(k4[i][1]), bfhi(k4[i][1])};
                *(f32x4*)(ok + 8 * i + 4) = (f32x4){bflo(k4[i][2]), bfhi(k4[i][2]), bflo(k4[i][3]), bfhi(k4[i][3])};
                *(f32x4*)(ov + 8 * i) = (f32x4){bflo(v4[i][0]), bfhi(v4[i][0]), bflo(v4[i][1]), bfhi(v4[i][1])};
                *(f32x4*)(ov + 8 * i + 4) = (f32x4){bflo(v4[i][2]), bfhi(v4[i][2]), bflo(v4[i][3]), bfhi(v4[i][3])};
            }
        }
    }
    LBAR();
    {
        const int g = wave >> 1, hq = kvh * 4 + g;
        const int l15 = lane & 15, q4 = lane >> 4;
        const float sink = p.in[16][hq];
        bf16_t* ya = (bf16_t*)(p.ws + WS_YA);
#pragma unroll 1
        for (int qp = 0; qp < 2; ++qp) {
        const int qbase = 64 * (wave & 1) + 32 * qp;
        bf16x8 qf[2][2];
#pragma unroll
        for (int qb = 0; qb < 2; ++qb) {
            const int qpos = blk * 128 + qbase + 16 * qb + l15;
            const bf16_t* zr = Z + (size_t)(b * 2048 + qpos) * NZ + hq * 64;
            qf[qb][0] = *(const bf16x8*)(zr + 8 * q4); qf[qb][1] = *(const bf16x8*)(zr + 32 + 8 * q4);
            const u32x4 own = __builtin_bit_cast(u32x4, qf[qb][0]); u32x4 oth;
#pragma unroll
            for (int w = 0; w < 4; ++w) oth[w] = (unsigned)__shfl_xor((int)own[w], 16);
            if (q4 < 2) {
                const f32x4* cs = (const f32x4*)(tab + (size_t)qpos * 16);
                const float sg = (q4 == 0) ? -1.f : 1.f; u32x4 r;
#pragma unroll
                for (int w = 0; w < 4; ++w) { const f32x4 c4 = cs[w];
                    r[w] = pk2(bflo(own[w]) * c4[0] + sg * bflo(oth[w]) * c4[1], bfhi(own[w]) * c4[2] + sg * bfhi(oth[w]) * c4[3]); }
                qf[qb][0] = __builtin_bit_cast(bf16x8, r);
            }
        }
        f32x4 o[4][2]; float mrow[2], lrow[2];
#pragma unroll
        for (int qb = 0; qb < 2; ++qb) { mrow[qb] = sink; lrow[qb] = (q4 == 0) ? 1.f : 0.f;
#pragma unroll
            for (int db = 0; db < 4; ++db) o[db][qb] = (f32x4){0.f, 0.f, 0.f, 0.f}; }
        int kt_lo = (wave & 1) ? 1 : 0; const int kt_hi = kt_lo + 3; if (blk == 0) kt_lo = 2;
        for (int kt = kt_lo; kt < kt_hi; ++kt) {
            f32x4 s[4][2];
#pragma unroll
            for (int kb = 0; kb < 4; ++kb) {
                const LAS bf16_t* kr = sK + (64 * kt + 16 * kb + l15) * 72 + 8 * q4;
                const bf16x8 kf0 = *(const LAS bf16x8*)kr, kf1 = *(const LAS bf16x8*)(kr + 32);
#pragma unroll
                for (int qb = 0; qb < 2; ++qb) { f32x4 z = (f32x4){0.f, 0.f, 0.f, 0.f}; z = MFMA16(kf0, qf[qb][0], z); s[kb][qb] = MFMA16(kf1, qf[qb][1], z); }
            }
#pragma unroll
            for (int qb = 0; qb < 2; ++qb) {
                const int i = qbase + 16 * qb + l15;
                float mx = -1e30f;
#pragma unroll
                for (int kb = 0; kb < 4; ++kb)
#pragma unroll
                    for (int r = 0; r < 4; ++r) { const int j = 64 * kt + 16 * kb + 4 * q4 + r; const bool ok = (unsigned)(j - i - 1) < 128u;
                        const float v = ok ? s[kb][qb][r] * 0.125f : -1e30f; s[kb][qb][r] = v; mx = fmaxf(mx, v); }
                mx = fmaxf(mx, __shfl_xor(mx, 16)); mx = fmaxf(mx, __shfl_xor(mx, 32));
                const float mn = fmaxf(mrow[qb], mx), alpha = __expf(mrow[qb] - mn); mrow[qb] = mn;
                float ls = lrow[qb] * alpha;
#pragma unroll
                for (int db = 0; db < 4; ++db) o[db][qb] = o[db][qb] * alpha;
#pragma unroll
                for (int kb = 0; kb < 4; ++kb)
#pragma unroll
                    for (int r = 0; r < 4; ++r) { const float pv = __expf(s[kb][qb][r] - mn); ls += pv; s[kb][qb][r] = pv; }
                lrow[qb] = ls;
            }
#pragma unroll
            for (int s2 = 0; s2 < 2; ++s2) {
                bf16x8 pb[2];
#pragma unroll
                for (int qb = 0; qb < 2; ++qb) pb[qb] = pack_p(s[2 * s2][qb], s[2 * s2 + 1][qb]);
#pragma unroll
                for (int db = 0; db < 4; ++db) {
                    const LAS bf16_t* vr = sVt + (16 * db + l15) * 264 + 64 * kt + 32 * s2 + 4 * q4;
                    const s16x4 lo = *(const LAS s16x4*)vr, hi = *(const LAS s16x4*)(vr + 16);
                    const bf16x8 vf = __builtin_shufflevector(lo, hi, 0, 1, 2, 3, 4, 5, 6, 7);
#pragma unroll
                    for (int qb = 0; qb < 2; ++qb) o[db][qb] = MFMA16(vf, pb[qb], o[db][qb]);
                }
            }
        }
#pragma unroll
        for (int qb = 0; qb < 2; ++qb) {
            float lt = lrow[qb]; lt += __shfl_xor(lt, 16); lt += __shfl_xor(lt, 32); const float inv = __builtin_amdgcn_rcpf(lt);
            const int row = b * 2048 + blk * 128 + qbase + 16 * qb + l15;
#pragma unroll
            for (int db = 0; db < 4; ++db) { u32x2 w; w.x = pk2(o[db][qb][0] * inv, o[db][qb][1] * inv); w.y = pk2(o[db][qb][2] * inv, o[db][qb][3] * inv);
                *(u32x2*)(ya + (size_t)row * 512 + hq * 64 + 16 * db + 4 * q4) = w; }
        }
        }
    }
    LBAR();
}

__device__ __forceinline__ void swa_sample_item(const Params& p, LAS unsigned char* lds, int item, int tid) {
    const int kv = item & 1, b = item >> 1;
    const bf16_t* Z = (const bf16_t*)(p.ws + WS_Z);
    const float* tab = (const float*)(p.ws + WS_ROPE);
    LAS float* sK = (LAS float*)lds;
    LAS float* sV = sK + 132 * 65;
    LAS float* sQ = sV + 132 * 64;
    LAS float* sP = sQ + 16 * 64;
    const float* cwk = p.in[3]; const float* cwv = p.in[4];
#pragma unroll 4
    for (int n = 0; n < 16; ++n) { const int e = tid + 512 * n, j = e >> 6, d = e & 63; const size_t a = ((size_t)(b * 128 + j) * 2 + kv) * 64 + d;
        sK[j * 65 + d] = cwk[a]; sV[j * 64 + d] = cwv[a]; }
    if (tid < 256) { const int t = tid >> 6, d = tid & 63; const bf16_t* zr = Z + (size_t)(MP + 4 * b + t) * NZ;
        sK[(128 + t) * 65 + d] = bf2f(zr[ZK + kv * 64 + d]); sV[(128 + t) * 64 + d] = bf2f(zr[ZV + kv * 64 + d]); }
#pragma unroll
    for (int n = 0; n < 2; ++n) { const int e = tid + 512 * n, qi = e >> 6, d = e & 63, t = qi >> 2, g = qi & 3;
        sQ[qi * 64 + d] = bf2f(Z[(size_t)(MP + 4 * b + t) * NZ + (kv * 4 + g) * 64 + d]); }
    LBAR();
    if (tid < 32) { const int t = tid >> 3, i = tid & 7; const float c = tab[((2048 + t) * 8 + i) * 2], s = tab[((2048 + t) * 8 + i) * 2 + 1];
        LAS float* x = sK + (128 + t) * 65; const float x1 = x[i], x2 = x[i + 8]; x[i] = x1 * c - x2 * s; x[i + 8] = x2 * c + x1 * s; }
    else if (tid >= 64 && tid < 192) { const int idx = tid - 64, qi = idx >> 3, i = idx & 7, t = qi >> 2; const float c = tab[((2048 + t) * 8 + i) * 2], s = tab[((2048 + t) * 8 + i) * 2 + 1];
        LAS float* x = sQ + qi * 64; const float x1 = x[i], x2 = x[i + 8]; x[i] = x1 * c - x2 * s; x[i + 8] = x2 * c + x1 * s; }
    LBAR();
#pragma unroll 4
    for (int n = 0; n < 16; ++n) { const int e = tid + 512 * n, jj = e >> 6, d = e & 63; const size_t a = ((size_t)(b * 128 + jj) * 2 + kv) * 64 + d;
        p.out[O_SWK + a] = sK[(jj + 4) * 65 + d]; p.out[O_SWV + a] = sV[(jj + 4) * 64 + d]; }
    const int qi = tid >> 5, jl = tid & 31, t = qi >> 2, g = qi & 3;
    const float sink = p.in[16][kv * 4 + g];
    float sc[5]; float mx = sink;
#pragma unroll
    for (int n = 0; n < 5; ++n) { const int j = jl + 32 * n; float v = -1e30f;
        if (j < 132 && j >= t + 1 && j <= t + 128) { float dot = 0.f;
#pragma unroll 16
            for (int d = 0; d < 64; ++d) dot += sQ[qi * 64 + d] * sK[j * 65 + d];
            v = dot * 0.125f; }
        sc[n] = v; mx = fmaxf(mx, v); }
#pragma unroll
    for (int o = 1; o < 32; o <<= 1) mx = fmaxf(mx, __shfl_xor(mx, o));
    float sum = 0.f;
#pragma unroll
    for (int n = 0; n < 5; ++n) { const float pv = __expf(sc[n] - mx); sum += pv; sc[n] = pv; }
#pragma unroll
    for (int o = 1; o < 32; o <<= 1) sum += __shfl_xor(sum, o);
    sum += __expf(sink - mx);
    const float inv = 1.f / sum;
#pragma unroll
    for (int n = 0; n < 5; ++n) { const int j = jl + 32 * n; if (j < 132) sP[qi * 132 + j] = sc[n] * inv; }
    LBAR();
    {
        const int d0 = jl * 2; float a0 = 0.f, a1 = 0.f;
        for (int j = 0; j < 132; ++j) { const float pj = sP[qi * 132 + j]; a0 += pj * sV[j * 64 + d0]; a1 += pj * sV[j * 64 + d0 + 1]; }
        bf16_t* ya = (bf16_t*)(p.ws + WS_YA);
        *(unsigned*)(ya + (size_t)(MP + 4 * b + t) * 512 + (kv * 4 + g) * 64 + d0) = pk2(a0, a1);
    }
    LBAR();
}

__device__ __forceinline__ float dn_ld(const bf16_t* Z, const float* cbuf, int row0, int tok, int cc) {
    return tok >= 0 ? bf2f(Z[(size_t)(row0 + tok) * NZ + ZDQ + cc]) : (cbuf ? cbuf[(3 + tok) * 1536 + cc] : 0.f);
}
template <int CG, int RS, int TB>
__device__ __forceinline__ void dn_scan_item(const Params& p, LAS unsigned char* lds, int row0, int L, int h, int cg, const float* S0, const float* cbuf, float* Sout, int tid) {
    static_assert(CG * RS == NTHR, "thread map");
    constexpr int R = 128 / RS;
    LAS float* sq = (LAS float*)lds;
    LAS float* sk = sq + TB * 128;
    LAS float* sv = sk + TB * 128;
    LAS float* sa = sv + TB * CG;
    LAS float* sb = sa + TB;
    const bf16_t* Z = (const bf16_t*)(p.ws + WS_Z);
    const float* cw = p.in[12];
    const float* gbuf = (const float*)(p.ws + WS_GB);
    bf16_t* oraw = (bf16_t*)(p.ws + WS_RA);
    const int c = tid / RS, rs = tid % RS;
    float S[R];
#pragma unroll
    for (int r = 0; r < R; ++r) S[r] = S0 ? S0[(size_t)(rs * R + r) * 128 + cg * CG + c] : 0.f;
    for (int t0 = 0; t0 < L; t0 += TB) {
        {
            const int ch = tid & 255, half = tid >> 8;
            const int cc = (ch < 128) ? (h * 128 + ch) : (512 + h * 128 + (ch - 128));
            const float w0 = cw[cc], w1 = cw[1536 + cc], w2 = cw[2 * 1536 + cc], w3 = cw[3 * 1536 + cc];
            constexpr int TH = TB / 2;
            const int tb = t0 + half * TH;
            float x0 = dn_ld(Z, cbuf, row0, tb - 3, cc), x1 = dn_ld(Z, cbuf, row0, tb - 2, cc), x2 = dn_ld(Z, cbuf, row0, tb - 1, cc);
            LAS float* dst = ((ch < 128) ? sq : sk) + (ch & 127);
#pragma unroll 4
            for (int i = 0; i < TH; ++i) { const float x3 = dn_ld(Z, cbuf, row0, tb + i, cc); dst[(half * TH + i) * 128] = silu(w0 * x0 + w1 * x1 + w2 * x2 + w3 * x3); x0 = x1; x1 = x2; x2 = x3; }
        }
        for (int e = tid; e < TB * CG; e += NTHR) { const int tt = e / CG, c2 = e % CG, cc = 1024 + h * 128 + cg * CG + c2, tok = t0 + tt;
            const float y = cw[cc] * dn_ld(Z, cbuf, row0, tok - 3, cc) + cw[1536 + cc] * dn_ld(Z, cbuf, row0, tok - 2, cc) + cw[2 * 1536 + cc] * dn_ld(Z, cbuf, row0, tok - 1, cc) + cw[3 * 1536 + cc] * dn_ld(Z, cbuf, row0, tok, cc);
            sv[tt * CG + c2] = silu(y); }
        if (tid < TB) { const size_t row = (size_t)(row0 + t0 + tid); sa[tid] = __expf(gbuf[row * 8 + h]); sb[tid] = gbuf[row * 8 + 4 + h]; }
        LBAR();
        for (int ri = tid >> 2; ri < 2 * TB; ri += NTHR / 4) {
            LAS float* rp = (ri < TB) ? (sq + ri * 128) : (sk + (ri - TB) * 128);
            const int sh = (tid & 3) + 4 * ri;
            float ss = 0.f;
#pragma unroll
            for (int i = 0; i < 32; ++i) { const float x = rp[(4 * i + sh) & 127]; ss += x * x; }
            ss += __shfl_xor(ss, 1); ss += __shfl_xor(ss, 2);
            const float scl = __builtin_amdgcn_rsqf(ss + EPS) * ((ri < TB) ? 0.08838834764831845f : 1.f);
#pragma unroll
            for (int i = 0; i < 32; ++i) rp[(4 * i + sh) & 127] *= scl;
        }
        LBAR();
        for (int tt = 0; tt < TB; ++tt) {
            const float a = sa[tt], bt = sb[tt], vv = sv[tt * CG + c];
            float kk[R]; float part = 0.f;
#pragma unroll
            for (int r = 0; r < R; ++r) { kk[r] = sk[tt * 128 + rs * R + r]; part += kk[r] * S[r]; }
#pragma unroll
            for (int o = 1; o < RS; o <<= 1) part += __shfl_xor(part, o);
            const float vn = bt * (vv - a * part);
            float op = 0.f;
#pragma unroll
            for (int r = 0; r < R; ++r) { S[r] = a * S[r] + kk[r] * vn; op += sq[tt * 128 + rs * R + r] * S[r]; }
#pragma unroll
            for (int o = 1; o < RS; o <<= 1) op += __shfl_xor(op, o);
            if (rs == 0) oraw[(size_t)(row0 + t0 + tt) * 512 + h * 128 + cg * CG + c] = (bf16_t)f2bf(op);
        }
        LBAR();
    }
#pragma unroll
    for (int r = 0; r < R; ++r) Sout[(size_t)(rs * R + r) * 128 + cg * CG + c] = S[r];
}


__device__ __forceinline__ bf16x8 frag64(const LAS bf16_t* ptr) {
    const s16x4 lo = *(const LAS s16x4*)ptr, hi = *(const LAS s16x4*)(ptr + 16);
    return __builtin_shufflevector(lo, hi, 0, 1, 2, 3, 4, 5, 6, 7);
}
__device__ __forceinline__ void dn_chunk_prep(const Params& p, LAS unsigned char* lds, int u, int tid, int lane, int wave) {
    const int n = u & 31, h = (u >> 5) & 3, b = u >> 7;
    const int row0 = b * 2048 + n * 64;
    LAS float* sq = (LAS float*)lds;
    LAS float* sk = sq + 64 * 128;
    LAS bf16_t* Kb = (LAS bf16_t*)(lds + 65536);
    LAS bf16_t* Qb = Kb + 64 * 136;
    LAS float* sgam = (LAS float*)(lds + 65536 + 2 * 17408);
    LAS float* sbeta = sgam + 64;
    LAS float* seg = sbeta + 64;
    LAS float* sek = seg + 64;
    LAS float* srq = sek + 64;
    LAS float* srk = srq + 64;
    LAS float* sA = sq;
    const bf16_t* Z = (const bf16_t*)(p.ws + WS_Z);
    const float* cw = p.in[12];
    const float* gbuf = (const float*)(p.ws + WS_GB);
    bf16_t* img = (bf16_t*)p.out + (size_t)u * 32768;
    bf16_t* mimg = (bf16_t*)(p.ws + WS_YB) + (size_t)u * 4096;
    const int type = wave >> 1, d = (wave & 1) * 64 + lane;
    float x[64];
    if (type < 3) {
        const int cc = type * 512 + h * 128 + d;
        const float w0 = cw[cc], w1 = cw[1536 + cc], w2 = cw[2 * 1536 + cc], w3 = cw[3 * 1536 + cc];
        const int tk = n * 64;
        const bf16_t* zrow = Z + ((size_t)(b * 2048 + tk) - 3) * NZ + ZDQ + type * 512 + h * 128 + (wave & 1) * 64;
        float x0 = 0.f, x1 = 0.f, x2 = 0.f;
        if (n > 0) { x0 = bf2f(zrow[lane]); x1 = bf2f(zrow[NZ + lane]); x2 = bf2f(zrow[2 * NZ + lane]); }
        zrow += 3 * NZ;
#pragma unroll
        for (int t8 = 0; t8 < 4; ++t8) {
#pragma unroll
            for (int e = 0; e < 16; ++e) { const float x3 = bf2f(zrow[lane]); zrow += NZ; x[16 * t8 + e] = silu(w0 * x0 + w1 * x1 + w2 * x2 + w3 * x3); x0 = x1; x1 = x2; x2 = x3; }
            asm volatile("" ::: "memory"); }
        if (type < 2) { LAS float* dst = (type ? sk : sq) + d;
#pragma unroll
            for (int t = 0; t < 64; ++t) dst[t * 128] = x[t]; }
    } else {
#pragma unroll
        for (int t = 0; t < 64; ++t) x[t] = 0.f;
        if (wave == 7) {
            float g = gbuf[(size_t)(row0 + lane) * 8 + h]; const float be = gbuf[(size_t)(row0 + lane) * 8 + 4 + h];
#pragma unroll
            for (int o = 1; o < 64; o <<= 1) { const float v = __shfl_up(g, o); if (lane >= o) g += v; }
            const float glast = __shfl(g, 63);
            sgam[lane] = g; sbeta[lane] = be; seg[lane] = __expf(g); sek[lane] = __expf(glast - g);
            if (lane == 0) ((float*)(p.ws + WS_GLAST))[u] = __expf(glast);
        }
    }
    LBAR();
    {
        const int ri = tid >> 2; LAS float* rp = (ri < 64) ? (sq + ri * 128) : (sk + (ri - 64) * 128);
        const int sh = (tid & 3) + 4 * ri; float ss = 0.f;
#pragma unroll
        for (int i = 0; i < 32; ++i) { const float v = rp[(4 * i + sh) & 127]; ss += v * v; }
        ss += __shfl_xor(ss, 1); ss += __shfl_xor(ss, 2);
        if ((tid & 3) == 0) { if (ri < 64) srq[ri] = __builtin_amdgcn_rsqf(ss + EPS) * 0.08838834764831845f; else srk[ri - 64] = __builtin_amdgcn_rsqf(ss + EPS); }
    }
    LBAR();
    {
        int vz; asm volatile("v_mov_b32 %0, 0" : "=v"(vz));
        if (type == 0) {
#pragma unroll
            for (int t8 = 0; t8 < 8; ++t8) {
#pragma unroll
                for (int e = 0; e < 8; ++e) { const int t = 8 * t8 + e; const float v = x[t] * srq[t + vz]; Qb[t * 136 + d] = (bf16_t)f2bf(v); img[8192 + t * 128 + d] = (bf16_t)f2bf(v * seg[t + vz]); }
                asm volatile("" ::: "memory"); }
        } else if (type == 1) {
            bf16_t* kd = img + 16384 + d * 64;
#pragma unroll
            for (int t8 = 0; t8 < 8; ++t8) { float v[8];
#pragma unroll
                for (int e = 0; e < 8; ++e) { const int t = 8 * t8 + e; const float kv = x[t] * srk[t + vz]; Kb[t * 136 + d] = (bf16_t)f2bf(kv); v[e] = kv * sek[t + vz]; x[t] = kv * sbeta[t + vz] * seg[t + vz]; }
                u32x4 w; w.x = pk2(v[0], v[1]); w.y = pk2(v[2], v[3]); w.z = pk2(v[4], v[5]); w.w = pk2(v[6], v[7]); *(u32x4*)(kd + 8 * t8) = w;
                asm volatile("" ::: "memory"); }
        } else if (type == 2) {
#pragma unroll
            for (int t8 = 0; t8 < 8; ++t8) {
#pragma unroll
                for (int e = 0; e < 8; ++e) x[8 * t8 + e] *= sbeta[8 * t8 + e + vz];
                asm volatile("" ::: "memory"); }
        }
    }
    LBAR();
    {
        const int it = wave & 3, kind = wave >> 2; const int l15 = lane & 15, q4 = lane >> 4;
        const LAS bf16_t* Ab = kind ? Qb : Kb;
        bf16x8 af[4];
#pragma unroll
        for (int ks = 0; ks < 4; ++ks) af[ks] = *(const LAS bf16x8*)(Ab + (16 * it + l15) * 136 + 32 * ks + 8 * q4);
#pragma unroll 1
        for (int jt = 0; jt < 4; ++jt) {
            f32x4 c = (f32x4){0.f, 0.f, 0.f, 0.f};
            if (jt <= it) {
#pragma unroll
                for (int ks = 0; ks < 4; ++ks) { const bf16x8 bfm = *(const LAS bf16x8*)(Kb + (16 * jt + l15) * 136 + 32 * ks + 8 * q4); c = MFMA16(af[ks], bfm, c); }
            }
            const int j = 16 * jt + l15; const float gj = sgam[j];
            f32x4 val;
#pragma unroll
            for (int r = 0; r < 4; ++r) { const int i = 16 * it + 4 * q4 + r; const float dec = __expf(fminf(sgam[i] - gj, 0.f));
                const float bi = kind ? 1.f : sbeta[i]; const bool keep = kind ? (i >= j) : (i > j);
                val[r] = keep ? bi * c[r] * dec : 0.f; }
            if (kind == 0) {
#pragma unroll
                for (int r = 0; r < 4; ++r) sA[(16 * it + 4 * q4 + r) * 64 + j] = val[r];
            } else {
#pragma unroll
                for (int r = 0; r < 4; ++r) mimg[(16 * it + 4 * q4 + r) * 64 + j] = (bf16_t)f2bf(val[r]);
            }
        }
    }
    LBAR();
    if (type == 1 || type == 2) {
#pragma unroll
        for (int i = 1; i < 64; ++i) { const LAS float* ar = sA + i * 64; f32x2 s01 = (f32x2){0.f, 0.f}, s23 = (f32x2){0.f, 0.f};
#pragma unroll
            for (int j = 0; j + 1 < i; j += 2) { const f32x2 av = (f32x2){ar[j], ar[j + 1]}, xv = (f32x2){x[j], x[j + 1]};
                if ((j & 2) == 0) s01 = __builtin_elementwise_fma(av, xv, s01); else s23 = __builtin_elementwise_fma(av, xv, s23); }
            float tail = 0.f; if (i & 1) tail = ar[i - 1] * x[i - 1];
            x[i] = x[i] - (((s01[0] + s01[1]) + (s23[0] + s23[1])) + tail); }
        if (type == 1) {
#pragma unroll
            for (int t = 0; t < 64; ++t) img[t * 128 + d] = (bf16_t)f2bf(x[t]);
        } else { bf16_t* ut = img + 24576 + d * 64;
#pragma unroll
            for (int t8 = 0; t8 < 8; ++t8) { u32x4 w; w.x = pk2(x[8 * t8], x[8 * t8 + 1]); w.y = pk2(x[8 * t8 + 2], x[8 * t8 + 3]); w.z = pk2(x[8 * t8 + 4], x[8 * t8 + 5]); w.w = pk2(x[8 * t8 + 6], x[8 * t8 + 7]); *(u32x4*)(ut + 8 * t8) = w; }
        }
    }
    LBAR();
}

constexpr int DN_IMG_ELEMS = 2 * 64 * 136 + 2 * 128 * 72 + 64 * 72;
__device__ __forceinline__ void dn_scan_chunked(const Params& p, LAS unsigned char* lds, int bh, int half, int tid, int lane, int wave) {
    const int b = bh >> 2, h = bh & 3;
    const bf16_t* img = (const bf16_t*)p.out + (size_t)bh * 32 * 32768;
    const bf16_t* mimg = (const bf16_t*)(p.ws + WS_YB) + (size_t)bh * 32 * 4096;
    const float* gl = (const float*)(p.ws + WS_GLAST) + bh * 32;
    bf16_t* oraw = (bf16_t*)(p.ws + WS_RA);
    const int l15 = lane & 15, q4 = lane >> 4, cb = half * 4 + (wave & 3);
    const bool active = wave < 4;
    u32x4 preA[9], preB[9];
#define DN_LOAD(pre, nn) do { _Pragma("unroll") for (int i = 0; i < 8; ++i) pre[i] = *(const u32x4*)(img + (size_t)(nn) * 32768 + (size_t)(tid + 512 * i) * 8); \
        pre[8] = *(const u32x4*)(mimg + (size_t)(nn) * 4096 + tid * 8); } while (0)
#define DN_STORE(buf, pre) do { LAS bf16_t* sW_ = (LAS bf16_t*)lds + (buf) * DN_IMG_ELEMS; LAS bf16_t* sQd_ = sW_ + 64 * 136; LAS bf16_t* sKdT_ = sQd_ + 64 * 136; LAS bf16_t* sUT_ = sKdT_ + 128 * 72; LAS bf16_t* sM_ = sUT_ + 128 * 72; \
        _Pragma("unroll") for (int i = 0; i < 8; ++i) { const int ee = tid * 8 + 4096 * (i & 1); \
            LAS bf16_t* dst = (i < 2) ? (sW_ + (ee >> 7) * 136 + (ee & 127)) : (i < 4) ? (sQd_ + (ee >> 7) * 136 + (ee & 127)) : (i < 6) ? (sKdT_ + (ee >> 6) * 72 + (ee & 63)) : (sUT_ + (ee >> 6) * 72 + (ee & 63)); \
            *(LAS u32x4*)dst = pre[i]; } \
        { const int ee = tid * 8; *(LAS u32x4*)(sM_ + (ee >> 6) * 72 + (ee & 63)) = pre[8]; } } while (0)
#define DN_BAR() do { asm volatile("s_waitcnt lgkmcnt(0)" ::: "memory"); __builtin_amdgcn_s_barrier(); asm volatile("" ::: "memory"); } while (0)
    f32x4 S[8];
#pragma unroll
    for (int i = 0; i < 8; ++i) S[i] = (f32x4){0.f, 0.f, 0.f, 0.f};
#define DN_STEP(n, cur) do { if (active) { __builtin_amdgcn_s_setprio(2); \
        const LAS bf16_t* sW = (const LAS bf16_t*)lds + (cur) * DN_IMG_ELEMS; const LAS bf16_t* sQd = sW + 64 * 136; const LAS bf16_t* sKdT = sQd + 64 * 136; const LAS bf16_t* sUT = sKdT + 128 * 72; const LAS bf16_t* sM = sUT + 128 * 72; \
        const float glast = gl[(n)]; \
        bf16x8 Sb[4]; \
        _Pragma("unroll") for (int s_ = 0; s_ < 4; ++s_) Sb[s_] = pack_p(S[2 * s_], S[2 * s_ + 1]); \
        f32x4 Vn[4], O[4]; \
        _Pragma("unroll") for (int rt = 0; rt < 4; ++rt) { \
            f32x4 p1 = (f32x4){0.f, 0.f, 0.f, 0.f}, oo = (f32x4){0.f, 0.f, 0.f, 0.f}; \
            _Pragma("unroll") for (int s_ = 0; s_ < 4; ++s_) { p1 = MFMA16(frag64(sW + (16 * rt + l15) * 136 + 32 * s_ + 4 * q4), Sb[s_], p1); oo = MFMA16(frag64(sQd + (16 * rt + l15) * 136 + 32 * s_ + 4 * q4), Sb[s_], oo); } \
            const s16x4 u4 = *(const LAS s16x4*)(sUT + (16 * cb + l15) * 72 + 16 * rt + 4 * q4); \
            Vn[rt] = (f32x4){bf2f((unsigned short)u4[0]), bf2f((unsigned short)u4[1]), bf2f((unsigned short)u4[2]), bf2f((unsigned short)u4[3])} - p1; O[rt] = oo; } \
        bf16x8 Vb[2]; Vb[0] = pack_p(Vn[0], Vn[1]); Vb[1] = pack_p(Vn[2], Vn[3]); \
        _Pragma("unroll") for (int rt = 0; rt < 4; ++rt) _Pragma("unroll") for (int s2 = 0; s2 < 2; ++s2) O[rt] = MFMA16(frag64(sM + (16 * rt + l15) * 72 + 32 * s2 + 4 * q4), Vb[s2], O[rt]); \
        _Pragma("unroll") for (int dkb = 0; dkb < 8; ++dkb) { f32x4 acc = S[dkb] * glast; \
            _Pragma("unroll") for (int s2 = 0; s2 < 2; ++s2) acc = MFMA16(frag64(sKdT + (16 * dkb + l15) * 72 + 32 * s2 + 4 * q4), Vb[s2], acc); \
            S[dkb] = acc; } \
        _Pragma("unroll") for (int rt = 0; rt < 4; ++rt) _Pragma("unroll") for (int r = 0; r < 4; ++r) oraw[(size_t)(b * 2048 + 64 * (n) + 16 * rt + 4 * q4 + r) * 512 + h * 128 + 16 * cb + l15] = (bf16_t)f2bf(O[rt][r]); \
    __builtin_amdgcn_s_setprio(0); } } while (0)
    DN_LOAD(preA, 0); DN_STORE(0, preA);
    DN_LOAD(preA, 1); DN_LOAD(preB, 2);
    DN_BAR();
#pragma unroll 1
    for (int n = 0; n < 32; n += 2) {
        DN_STORE(1, preA);
        if (n + 3 < 32) DN_LOAD(preA, n + 3);
        DN_STEP(n, 0);
        DN_BAR();
        if (n + 2 < 32) DN_STORE(0, preB);
        if (n + 4 < 32) DN_LOAD(preB, n + 4);
        DN_STEP(n + 1, 1);
        DN_BAR();
    }
#undef DN_STEP
#undef DN_BAR
#undef DN_LOAD
#undef DN_STORE
    float* so = p.out + O_PDS + (size_t)bh * 16384;
    if (active)
#pragma unroll
    for (int dkb = 0; dkb < 8; ++dkb)
#pragma unroll
        for (int r = 0; r < 4; ++r) so[(size_t)(16 * dkb + 4 * q4 + r) * 128 + 16 * cb + l15] = S[dkb][r];
}


template <int K, class F1, int LDA = K>
__device__ __forceinline__ void skinny_sample_gemm(const bf16_t* A  , const bf16_t* Bt  , int bid, int G, int lane, int wave, const F1& f1) {
    const int l15 = lane & 15, q4 = lane >> 4;
    for (int t = bid; t < 256; t += G) {
        const int rg = t >> 3, cgp = t & 7;
        const bf16_t* ap = A + (size_t)(16 * rg + l15) * LDA + 8 * q4;
        const bf16_t* bp = Bt + (size_t)(128 * cgp + 16 * wave + l15) * K + 8 * q4;
        f32x4 acc = (f32x4){0.f, 0.f, 0.f, 0.f};
#pragma unroll 8
        for (int ks = 0; ks < K / 32; ++ks) { const bf16x8 a = *(const bf16x8*)(ap + 32 * ks), b = *(const bf16x8*)(bp + 32 * ks); acc = MFMA16(a, b, acc); }
        const int col = 128 * cgp + 16 * wave + l15;
#pragma unroll
        for (int r = 0; r < 4; ++r) f1(MP + 16 * rg + 4 * q4 + r, col, acc[r]);
    }
}
struct FGateA1 { const bf16_t* Z; bf16_t* t1;
    __device__ __forceinline__ void operator()(int row, int col, float v) const { t1[(size_t)row * 1024 + col] = (bf16_t)f2bf(sigm(bf2f(Z[(size_t)row * NZ + ZGA + col])) * v); } };
struct FGateB1 { const bf16_t* Z; const bf16_t* t1; bf16_t* mix;
    __device__ __forceinline__ void operator()(int row, int col, float v) const { mix[(size_t)row * 1024 + col] = (bf16_t)f2bf(bf2f(t1[(size_t)row * 1024 + col]) + sigm(bf2f(Z[(size_t)row * NZ + ZGB + col])) * v); } };
struct FResX1 { const float* xs; float* h;
    __device__ __forceinline__ void operator()(int row, int col, float v) const { h[(size_t)row * 1024 + col] = xs[(size_t)(row - MP) * 1024 + col] + v; } };
struct FAcc1 { float* h;
    __device__ __forceinline__ void operator()(int row, int col, float v) const { h[(size_t)row * 1024 + col] += v; } };

__device__ __forceinline__ void xattn_stage(LAS unsigned char* lds, const float* kb, const float* vb, int h, int tid) {
    LAS bf16_t* sK = (LAS bf16_t*)lds;
    LAS bf16_t* sVt = (LAS bf16_t*)(lds + 69632);
    const int key = tid >> 1, half = tid & 1;
    const float* kr = kb + ((size_t)key * 4 + h) * 128 + 64 * half;
    const float* vr = vb + ((size_t)key * 4 + h) * 128 + 64 * half;
#pragma unroll
    for (int i = 0; i < 8; ++i) { const f32x4 a = *(const f32x4*)(kr + 8 * i), b2 = *(const f32x4*)(kr + 8 * i + 4);
        u32x4 w; w.x = pk2(a[0], a[1]); w.y = pk2(a[2], a[3]); w.z = pk2(b2[0], b2[1]); w.w = pk2(b2[2], b2[3]);
        *(LAS u32x4*)(sK + key * 136 + 64 * half + 8 * i) = w; }
#pragma unroll
    for (int i = 0; i < 16; ++i) { const f32x4 a = *(const f32x4*)(vr + 4 * i);
#pragma unroll
        for (int e = 0; e < 4; ++e) sVt[(64 * half + 4 * i + e) * 264 + key] = (bf16_t)f2bf(a[e]); }
}
template <int NQB>
__device__ __forceinline__ void xattn_wave(const Params& p, const LAS unsigned char* lds, int rowbase, int nvalid, int h, int lane) {
    const LAS bf16_t* sK = (const LAS bf16_t*)lds;
    const LAS bf16_t* sVt = (const LAS bf16_t*)(lds + 69632);
    const bf16_t* hq = (const bf16_t*)(p.ws + WS_Z + ZO_HQ);
    bf16_t* xo = (bf16_t*)(p.ws + WS_Z + ZO_XO);
    const int l15 = lane & 15, q4 = lane >> 4;
    const int lr = (l15 < nvalid) ? l15 : (nvalid - 1);
    bf16x8 qf[NQB][4];
#pragma unroll
    for (int qb = 0; qb < NQB; ++qb)
#pragma unroll
        for (int ks = 0; ks < 4; ++ks) qf[qb][ks] = *(const bf16x8*)(hq + (size_t)(rowbase + 16 * qb + lr) * 512 + h * 128 + 32 * ks + 8 * q4);
    f32x4 o[8][NQB]; float mrow[NQB], lrow[NQB];
#pragma unroll
    for (int qb = 0; qb < NQB; ++qb) { mrow[qb] = -1e30f; lrow[qb] = 0.f;
#pragma unroll
        for (int db = 0; db < 8; ++db) o[db][qb] = (f32x4){0.f, 0.f, 0.f, 0.f}; }
    for (int kt = 0; kt < 4; ++kt) {
        f32x4 s[4][NQB];
#pragma unroll
        for (int kb = 0; kb < 4; ++kb) {
            const LAS bf16_t* kr = sK + (64 * kt + 16 * kb + l15) * 136 + 8 * q4;
#pragma unroll
            for (int qb = 0; qb < NQB; ++qb) s[kb][qb] = (f32x4){0.f, 0.f, 0.f, 0.f};
#pragma unroll
            for (int ks = 0; ks < 4; ++ks) { const bf16x8 kf = *(const LAS bf16x8*)(kr + 32 * ks);
#pragma unroll
                for (int qb = 0; qb < NQB; ++qb) s[kb][qb] = MFMA16(kf, qf[qb][ks], s[kb][qb]); }
        }
#pragma unroll
        for (int qb = 0; qb < NQB; ++qb) {
            float mx = -1e30f;
#pragma unroll
            for (int kb = 0; kb < 4; ++kb)
#pragma unroll
                for (int r = 0; r < 4; ++r) { const float v = s[kb][qb][r] * 0.08838834764831845f; s[kb][qb][r] = v; mx = fmaxf(mx, v); }
            mx = fmaxf(mx, __shfl_xor(mx, 16)); mx = fmaxf(mx, __shfl_xor(mx, 32));
            const float mn = fmaxf(mrow[qb], mx), alpha = __expf(mrow[qb] - mn); mrow[qb] = mn;
            float ls = lrow[qb] * alpha;
#pragma unroll
            for (int db = 0; db < 8; ++db) o[db][qb] = o[db][qb] * alpha;
#pragma unroll
            for (int kb = 0; kb < 4; ++kb)
#pragma unroll
                for (int r = 0; r < 4; ++r) { const float pv = __expf(s[kb][qb][r] - mn); ls += pv; s[kb][qb][r] = pv; }
            lrow[qb] = ls;
        }
#pragma unroll
        for (int s2 = 0; s2 < 2; ++s2) {
            bf16x8 pb[NQB];
#pragma unroll
            for (int qb = 0; qb < NQB; ++qb) pb[qb] = pack_p(s[2 * s2][qb], s[2 * s2 + 1][qb]);
#pragma unroll
            for (int db = 0; db < 8; ++db) {
                const LAS bf16_t* vr = sVt + (16 * db + l15) * 264 + 64 * kt + 32 * s2 + 4 * q4;
                const s16x4 lo = *(const LAS s16x4*)vr, hi = *(const LAS s16x4*)(vr + 16);
                const bf16x8 vf = __builtin_shufflevector(lo, hi, 0, 1, 2, 3, 4, 5, 6, 7);
#pragma unroll
                for (int qb = 0; qb < NQB; ++qb) o[db][qb] = MFMA16(vf, pb[qb], o[db][qb]);
            }
        }
    }
#pragma unroll
    for (int qb = 0; qb < NQB; ++qb) {
        float lt = lrow[qb]; lt += __shfl_xor(lt, 16); lt += __shfl_xor(lt, 32); const float inv = __builtin_amdgcn_rcpf(lt);
        if (l15 < nvalid) { const size_t row = (size_t)(rowbase + 16 * qb + l15);
#pragma unroll
            for (int db = 0; db < 8; ++db) { u32x2 w; w.x = pk2(o[db][qb][0] * inv, o[db][qb][1] * inv); w.y = pk2(o[db][qb][2] * inv, o[db][qb][3] * inv);
                *(u32x2*)(xo + row * 512 + h * 128 + 16 * db + 4 * q4) = w; } }
    }
}

template <bool FINAL>
__device__ __forceinline__ void rms_pass(const Params& p, const float* g, int gw, int NGW, int lane) {
    bf16_t* hn = (bf16_t*)(p.ws + WS_RA);
    for (int m = gw; m < MT; m += 2 * NGW) {
        const int mb = (m + NGW < MT) ? (m + NGW) : m;
        f32x4* xa = (f32x4*)(p.out + (size_t)m * 1024); f32x4* xb = (f32x4*)(p.out + (size_t)mb * 1024);
        f32x4 va[4], vb[4]; float sa = 0.f, sb = 0.f;
#pragma unroll
        for (int j = 0; j < 4; ++j) { va[j] = xa[lane + 64 * j]; vb[j] = xb[lane + 64 * j]; }
#pragma unroll
        for (int j = 0; j < 4; ++j) { sa += (va[j][0] * va[j][0] + va[j][1] * va[j][1]) + (va[j][2] * va[j][2] + va[j][3] * va[j][3]); sb += (vb[j][0] * vb[j][0] + vb[j][1] * vb[j][1]) + (vb[j][2] * vb[j][2] + vb[j][3] * vb[j][3]); }
#pragma unroll
        for (int o = 1; o < 64; o <<= 1) { sa += __shfl_xor(sa, o); sb += __shfl_xor(sb, o); }
        const float ra = __builtin_amdgcn_rsqf(sa * (1.f / 1024.f) + EPS), rb = __builtin_amdgcn_rsqf(sb * (1.f / 1024.f) + EPS);
#pragma unroll
        for (int j = 0; j < 4; ++j) { const f32x4 gg = ((const f32x4*)g)[lane + 64 * j]; const f32x4 ya = va[j] * ra * gg, yb = vb[j] * rb * gg;
            if constexpr (FINAL) { xa[lane + 64 * j] = ya; if (mb != m) xb[lane + 64 * j] = yb; }
            else { u32x2 w; w.x = pk2(ya[0], ya[1]); w.y = pk2(ya[2], ya[3]); ((u32x2*)(hn + (size_t)m * 1024))[lane + 64 * j] = w;
                   u32x2 w2; w2.x = pk2(yb[0], yb[1]); w2.y = pk2(yb[2], yb[3]); ((u32x2*)(hn + (size_t)mb * 1024))[lane + 64 * j] = w2; } }
    }
}

__device__ __forceinline__ void ffn_gate_chunk(const Params& p, int row_lo, int nrows, int gtid, int GT) {
    const bf16_t* UG = (const bf16_t*)(p.ws + WS_Z + ZO_UG);
    bf16_t* act = (bf16_t*)(p.ws + WS_Z + ZO_UG) + 2816;
    const float* fcw = p.in[27]; const float* sfc = p.in[9];
    const int np = (row_lo + nrows > MP) ? (MP - row_lo) : nrows;
    for (int it = gtid; it < (np >> 3) * 352; it += GT) {
        const int lr0 = (it / 352) * 8, c = (it % 352) * 8, t0 = (row_lo + lr0) & 2047, bs = (row_lo + lr0) >> 11;
        const bf16_t* ub = UG + (size_t)lr0 * 5632 + c;
        u32x4 uu[8], gg[8], h1 = (u32x4){0u, 0u, 0u, 0u}, h0 = (u32x4){0u, 0u, 0u, 0u};
        if (t0 != 0) { h1 = *(const u32x4*)(ub - 5632); h0 = *(const u32x4*)(ub - 2 * 5632); }
#pragma unroll
        for (int i = 0; i < 8; ++i) { uu[i] = *(const u32x4*)(ub + (size_t)i * 5632); gg[i] = *(const u32x4*)(ub + (size_t)i * 5632 + 2816); }
        const f32x4 wa0 = *(const f32x4*)(fcw + c), wa1 = *(const f32x4*)(fcw + c + 4), wb0 = *(const f32x4*)(fcw + 2816 + c), wb1 = *(const f32x4*)(fcw + 2816 + c + 4), wc0 = *(const f32x4*)(fcw + 2 * 2816 + c), wc1 = *(const f32x4*)(fcw + 2 * 2816 + c + 4);
#pragma unroll
        for (int i = 0; i < 8; ++i) {
            const u32x4 x2 = uu[i]; u32x4 o;
#pragma unroll
            for (int w = 0; w < 4; ++w) {
                const float k0 = (w < 2) ? wa0[2 * (w & 1)] : wa1[2 * (w & 1)], k0b = (w < 2) ? wa0[2 * (w & 1) + 1] : wa1[2 * (w & 1) + 1];
                const float k1 = (w < 2) ? wb0[2 * (w & 1)] : wb1[2 * (w & 1)], k1b = (w < 2) ? wb0[2 * (w & 1) + 1] : wb1[2 * (w & 1) + 1];
                const float k2 = (w < 2) ? wc0[2 * (w & 1)] : wc1[2 * (w & 1)], k2b = (w < 2) ? wc0[2 * (w & 1) + 1] : wc1[2 * (w & 1) + 1];
                const float ya = k0 * bflo(h0[w]) + k1 * bflo(h1[w]) + k2 * bflo(x2[w]), yb2 = k0b * bfhi(h0[w]) + k1b * bfhi(h1[w]) + k2b * bfhi(x2[w]);
                o[w] = pk2(silu(ya) * bflo(gg[i][w]), silu(yb2) * bfhi(gg[i][w])); }
            *(u32x4*)(act + (size_t)(row_lo + lr0 + i) * 5632 + c) = o;
            if (t0 + i >= 2046) { float* od = p.out + O_PFC + ((size_t)bs * 2 + (t0 + i - 2046)) * 2816 + c;
                *(f32x4*)od = (f32x4){bflo(x2[0]), bfhi(x2[0]), bflo(x2[1]), bfhi(x2[1])}; *(f32x4*)(od + 4) = (f32x4){bflo(x2[2]), bfhi(x2[2]), bflo(x2[3]), bfhi(x2[3])}; }
            h0 = h1; h1 = x2;
        }
    }
    const int items = (nrows - np) * 352;
    for (int it = gtid; it < items; it += GT) {
        const int lr = np + it / 352, c = (it % 352) * 8, r = row_lo + lr;
        const bool samp = true; const int t = (r - MP) & 3; const int bs = (r - MP) >> 2;
        const u32x4 u0 = *(const u32x4*)(UG + (size_t)lr * 5632 + c), gv = *(const u32x4*)(UG + (size_t)lr * 5632 + 2816 + c);
        float x0[8], x1[8], x2[8], gvf[8];
#pragma unroll
        for (int w = 0; w < 4; ++w) { x2[2 * w] = bflo(u0[w]); x2[2 * w + 1] = bfhi(u0[w]); gvf[2 * w] = bflo(gv[w]); gvf[2 * w + 1] = bfhi(gv[w]); }
        if (t >= 1) { const u32x4 a = *(const u32x4*)(UG + (size_t)(lr - 1) * 5632 + c);
#pragma unroll
            for (int w = 0; w < 4; ++w) { x1[2 * w] = bflo(a[w]); x1[2 * w + 1] = bfhi(a[w]); } }
        else { const float* s = sfc + ((size_t)bs * 2 + 1) * 2816 + c;
#pragma unroll
            for (int e = 0; e < 8; ++e) x1[e] = s[e]; }
        if (t >= 2) { const u32x4 a = *(const u32x4*)(UG + (size_t)(lr - 2) * 5632 + c);
#pragma unroll
            for (int w = 0; w < 4; ++w) { x0[2 * w] = bflo(a[w]); x0[2 * w + 1] = bfhi(a[w]); } }
        else { const float* s = sfc + ((size_t)bs * 2 + t) * 2816 + c;
#pragma unroll
            for (int e = 0; e < 8; ++e) x0[e] = s[e]; }
        float a8[8];
#pragma unroll
        for (int e = 0; e < 8; ++e) { const float y = fcw[c + e] * x0[e] + fcw[2816 + c + e] * x1[e] + fcw[2 * 2816 + c + e] * x2[e]; a8[e] = silu(y) * gvf[e]; }
        u32x4 o; o.x = pk2(a8[0], a8[1]); o.y = pk2(a8[2], a8[3]); o.z = pk2(a8[4], a8[5]); o.w = pk2(a8[6], a8[7]);
        *(u32x4*)(act + (size_t)(row_lo + lr) * 5632 + c) = o;
        if (samp && t >= 2) { float* od = p.out + O_SFC + ((size_t)bs * 2 + (t - 2)) * 2816 + c;
            *(f32x4*)od = (f32x4){x2[0], x2[1], x2[2], x2[3]}; *(f32x4*)(od + 4) = (f32x4){x2[4], x2[5], x2[6], x2[7]}; }
    }
}

#define XB_TMO      128
#define XB_XCNT(j)  (256  + 64 * (j))
#define XB_XSUB(j)  (1280 + 64 * (j))
#define XB_XGEN(j)  (2304 + 64 * (j))
#define XB_TOP      3328
#define XB_TOPGEN   3392
#define XCD_BAR_WORDS 3456
#define XB_SPIN_CAP (1u << 18)

__device__ __forceinline__ unsigned xb_ld(unsigned* p)              { return __hip_atomic_load(p, __ATOMIC_RELAXED, __HIP_MEMORY_SCOPE_AGENT); }
__device__ __forceinline__ unsigned xb_add(unsigned* p, unsigned v) { return __hip_atomic_fetch_add(p, v, __ATOMIC_RELAXED, __HIP_MEMORY_SCOPE_AGENT); }
__device__ __forceinline__ unsigned xb_xcc_id() { return (unsigned)__builtin_amdgcn_s_getreg((3 << 11) | 20) & 0xFu; }
#define XB_SPIN(cond, bar) do { unsigned _sp = 0; while (cond) { __builtin_amdgcn_s_sleep(1); \
    if ((++_sp & 255u) == 0u) { if (xb_ld(&(bar)[XB_TMO])) break; if (_sp > XB_SPIN_CAP) { atomicAdd(&(bar)[XB_TMO], 1u); break; } } } } while (0)

struct XcdBarrier {
    unsigned* bar; unsigned x;
    volatile LAS unsigned* st;
};

__device__ __forceinline__ XcdBarrier xcd_barrier_post(unsigned* bar, volatile LAS unsigned* st) {
    XcdBarrier b; b.bar = bar; b.x = xb_xcc_id(); b.st = st;
    if (threadIdx.x == 0) (void)xb_add(&bar[XB_XCNT(b.x)], 1u);
    return b;
}
__device__ __forceinline__ void xcd_barrier_complete(unsigned* bar, unsigned x, unsigned& nloc, unsigned& nx) {
    const unsigned G = gridDim.x * gridDim.y * gridDim.z;
    unsigned sum, cnt, mine, sp = 0u;
    for (;;) {
        sum = 0u; cnt = 0u; mine = 0u;
#pragma unroll
        for (unsigned j = 0; j < 16; ++j) { const unsigned c = xb_ld(&bar[XB_XCNT(j)]); sum += c; cnt += (c > 0u) ? 1u : 0u; mine = (j == x) ? c : mine; }
        if (sum == G) break;
        __builtin_amdgcn_s_sleep(1);
        if ((++sp & 255u) == 0u) { if (xb_ld(&bar[XB_TMO])) break; if (sp > XB_SPIN_CAP) { atomicAdd(&bar[XB_TMO], 1u); break; } }
    }
    nloc = mine > 0u ? mine : 1u; nx = cnt > 0u ? cnt : 1u;
}

__device__ __attribute__((noinline)) void xcd_barrier(unsigned* bar_, unsigned x_, volatile LAS unsigned* st_) {
    XcdBarrier b; b.bar = bar_; b.x = x_; b.st = st_;
    asm volatile("s_waitcnt vmcnt(0)" ::: "memory");
    __syncthreads();
    if (threadIdx.x == 0) {
        unsigned* bar = b.bar;
        __builtin_amdgcn_s_waitcnt(0);
        unsigned nloc = b.st[0], nx = b.st[1];
        if (nloc == 0u) { xcd_barrier_complete(bar, b.x, nloc, nx); b.st[0] = nloc; b.st[1] = nx; }
        const unsigned old = xb_add(&bar[XB_XSUB(b.x)], 1u);
        const unsigned gen = old / nloc;
        if (old + 1u == (gen + 1u) * nloc) {
            __builtin_amdgcn_fence(__ATOMIC_RELEASE, "agent");
            asm volatile("s_waitcnt vmcnt(0)" ::: "memory");
            const unsigned og = xb_add(&bar[XB_TOP], 1u);
            const unsigned tg = og / nx;
            if (og + 1u == (tg + 1u) * nx) xb_add(&bar[XB_TOPGEN], 1u);
            else XB_SPIN(xb_ld(&bar[XB_TOPGEN]) == tg, bar);
            __builtin_amdgcn_fence(__ATOMIC_ACQUIRE, "agent");
            xb_add(&bar[XB_XGEN(b.x)], 1u);
            asm volatile("s_waitcnt vmcnt(0)" ::: "memory");
        } else {
            XB_SPIN(xb_ld(&bar[XB_XGEN(b.x)]) == gen, bar);
            __builtin_amdgcn_fence(__ATOMIC_ACQUIRE, "agent");
            asm volatile("s_waitcnt vmcnt(0)" ::: "memory");
        }
    }
    __syncthreads();
}

__global__ void __launch_bounds__(NTHR, 2) mega_fwd(Params p) {
    extern __shared__ __attribute__((aligned(16))) unsigned char lds_raw[];
    LAS unsigned char* lds = (LAS unsigned char*)lds_raw;
    cg::grid_group grid = cg::this_grid();
#define PH_IDS() int tid = threadIdx.x; asm volatile("" : "+v"(tid)); const int lane = tid & 63, wave = __builtin_amdgcn_readfirstlane(tid >> 6); \
    const int G = gridDim.x, bid = blockIdx.x; const int gw = bid * 8 + wave, NGW = G * 8, gtid = bid * NTHR + tid, GT = G * NTHR; \
    unsigned char* ws = p.ws; bf16_t* RA = (bf16_t*)(ws + WS_RA); bf16_t* Zb = (bf16_t*)(ws + WS_Z); float* hres = p.out; \
    (void)lane; (void)wave; (void)G; (void)bid; (void)gw; (void)NGW; (void)gtid; (void)GT; (void)RA; (void)Zb; (void)hres
#define BST() ((volatile LAS unsigned*)(lds + LDS_BYTES - 16))
#define GSYNC() xcd_barrier((unsigned*)(p.ws + WS_CTL), xb_xcc_id(), BST())
    {
        if (threadIdx.x == 0) { BST()[0] = 0u; BST()[1] = 0u; }
        __syncthreads();
        (void)xcd_barrier_post((unsigned*)(p.ws + WS_CTL), BST());
    }

    { PH_IDS();
    p0_prologue(p, lds, tid, lane, wave, G);
    }
    GSYNC();

    { PH_IDS();
    { pg8::Gemm g{RA, (const bf16_t*)(ws + WS_WIN), MT, NZ, 1024, 1024}; pg8::StaticOrder S; S.init(MT, NZ, G, bid);
      pg8::EpiBf16 E{Zb, NZ};
      pg8::gemm_phase<pg8::EpiBf16, pg8::StaticOrder, true, true>(lds, g, S, E); }
    { const int tb1 = (G == 256) ? 230 : 0;
      if (bid >= tb1) { LAS float* scr = (LAS float*)(lds + wave * 16384);
        constexpr int J5 = 16 * 32, J6 = 16 * 16, J3 = 8 * 32;
        for (int it = (bid - tb1) * 8 + wave; it < J5 + J6 + J5 + J3; it += (G - tb1) * 8) { int r = it;
            if (r < J5) { transpose_item(p.in[19], 1024, 0, 1024, 1024, (bf16_t*)(ws + WS_WMO), 0, scr, r, lane); continue; } r -= J5;
            if (r < J6) { transpose_item(p.in[22], 512, 0, 1024, 512, (bf16_t*)(ws + WS_WXQ), 0, scr, r, lane); continue; } r -= J6;
            if (r < J5) { transpose_item(p.in[23], 1024, 0, 1024, 1024, (bf16_t*)(ws + WS_WXKV), 0, scr, r, lane); continue; } r -= J5;
            transpose_item(p.in[24], 1024, 0, 512, 1024, (bf16_t*)(ws + WS_WXO), 0, scr, r, lane); } } }
    }
    GSYNC();

    { PH_IDS();
    for (int u = bid; u < 1024; u += G) dn_chunk_prep(p, lds, u, tid, lane, wave);
    }
    GSYNC();

    { PH_IDS();
    {
        const int nA = (G >= 128) ? 64 : G / 2;
        if (bid < nA) {
            for (int it = bid; it < 64; it += nA) dn_scan_chunked(p, lds, (it & 7) + 8 * (it >> 4), (it >> 3) & 1, tid, lane, wave);
        } else {
            const int idx = bid - nA, nB = G - nA;
            for (int it = idx; it < 256; it += nB) swa_prompt_item(p, lds, it, tid, lane, wave);
            for (int it = idx; it < 256; it += nB) swa_sample_item(p, lds, it, tid);
            for (int it = idx; it < 512; it += nB) { const int h = it & 3, s = it >> 2;
                dn_scan_item<128, 4, 4>(p, lds, MP + 4 * s, 4, h, 0, p.in[6] + (size_t)(s * 4 + h) * 16384, p.in[5] + (size_t)s * 3 * 1536, p.out + O_SDS + (size_t)(s * 4 + h) * 16384, tid); }
        }
    }
    }
    GSYNC();

    { PH_IDS();
    {
        const bf16_t* oraw = (const bf16_t*)(ws + WS_RA); const float* gn = p.in[15]; bf16_t* yb = (bf16_t*)(ws + WS_YB);
        {
            const int c8 = (lane & 15) * 8, ch = (lane >> 4) * 128 + c8;
            const f32x4 g0 = *(const f32x4*)(gn + c8), g1 = *(const f32x4*)(gn + c8 + 4);
            for (int m = gw; m < MT; m += 2 * NGW) {
                const int mb = (m + NGW < MT) ? (m + NGW) : m;
                const u32x4 oa = *(const u32x4*)(oraw + (size_t)m * 512 + ch), ob = *(const u32x4*)(oraw + (size_t)mb * 512 + ch);
                const f32x4 a0 = (f32x4){bflo(oa.x), bfhi(oa.x), bflo(oa.y), bfhi(oa.y)}, a1 = (f32x4){bflo(oa.z), bfhi(oa.z), bflo(oa.w), bfhi(oa.w)};
                const f32x4 b0 = (f32x4){bflo(ob.x), bfhi(ob.x), bflo(ob.y), bfhi(ob.y)}, b1 = (f32x4){bflo(ob.z), bfhi(ob.z), bflo(ob.w), bfhi(ob.w)};
                const u32x4 za = *(const u32x4*)(Zb + (size_t)m * NZ + ZDZ + ch), zb = *(const u32x4*)(Zb + (size_t)mb * NZ + ZDZ + ch);
                float sa = (a0[0] * a0[0] + a0[1] * a0[1]) + (a0[2] * a0[2] + a0[3] * a0[3]) + (a1[0] * a1[0] + a1[1] * a1[1]) + (a1[2] * a1[2] + a1[3] * a1[3]);
                float sb = (b0[0] * b0[0] + b0[1] * b0[1]) + (b0[2] * b0[2] + b0[3] * b0[3]) + (b1[0] * b1[0] + b1[1] * b1[1]) + (b1[2] * b1[2] + b1[3] * b1[3]);
#pragma unroll
                for (int o = 1; o < 16; o <<= 1) { sa += __shfl_xor(sa, o); sb += __shfl_xor(sb, o); }
                const float ra = __builtin_amdgcn_rsqf(sa * (1.f / 128.f) + EPS), rb = __builtin_amdgcn_rsqf(sb * (1.f / 128.f) + EPS);
                u32x4 wa, wb;
                wa.x = pk2(a0[0] * ra * g0[0] * silu(bflo(za.x)), a0[1] * ra * g0[1] * silu(bfhi(za.x))); wa.y = pk2(a0[2] * ra * g0[2] * silu(bflo(za.y)), a0[3] * ra * g0[3] * silu(bfhi(za.y)));
                wa.z = pk2(a1[0] * ra * g1[0] * silu(bflo(za.z)), a1[1] * ra * g1[1] * silu(bfhi(za.z))); wa.w = pk2(a1[2] * ra * g1[2] * silu(bflo(za.w)), a1[3] * ra * g1[3] * silu(bfhi(za.w)));
                wb.x = pk2(b0[0] * rb * g0[0] * silu(bflo(zb.x)), b0[1] * rb * g0[1] * silu(bfhi(zb.x))); wb.y = pk2(b0[2] * rb * g0[2] * silu(bflo(zb.y)), b0[3] * rb * g0[3] * silu(bfhi(zb.y)));
                wb.z = pk2(b1[0] * rb * g1[0] * silu(bflo(zb.z)), b1[1] * rb * g1[1] * silu(bfhi(zb.z))); wb.w = pk2(b1[2] * rb * g1[2] * silu(bflo(zb.w)), b1[3] * rb * g1[3] * silu(bfhi(zb.w)));
                *(u32x4*)(yb + (size_t)m * 512 + ch) = wa; *(u32x4*)(yb + (size_t)mb * 512 + ch) = wb;
            }
        }
        for (int e = gtid; e < 8 * 3 * 1536; e += GT) { const int cc = e % 1536, r = (e / 1536) % 3, b = e / (3 * 1536);
            p.out[O_PDC + e] = bf2f(Zb[(size_t)(b * 2048 + 2045 + r) * NZ + ZDQ + cc]); }
        for (int e = gtid; e < 128 * 3 * 1536; e += GT) { const int cc = e % 1536, r = (e / 1536) % 3, b = e / (3 * 1536);
            p.out[O_SDC + e] = bf2f(Zb[(size_t)(MP + 4 * b + 1 + r) * NZ + ZDQ + cc]); }
        pg8::Gemm g{(const bf16_t*)(ws + WS_YA), (const bf16_t*)(ws + WS_WA), MP, 1024, 512, 512}; pg8::StaticOrder S; S.init(MP, 1024, G, bid);
        pg8::EpiF8P<FGateA8> E{FGateA8{Zb, (bf16_t*)hres}};
        pg8::gemm_phase<pg8::EpiF8P<FGateA8>, pg8::StaticOrder, true, true>(lds, g, S, E);
        skinny_sample_gemm<512>((const bf16_t*)(ws + WS_YA) + (size_t)MP * 512, (const bf16_t*)(ws + WS_WA), bid, G, lane, wave, FGateA1{Zb, (bf16_t*)hres});
    }
    }
    GSYNC();

    { PH_IDS();
    { pg8::Gemm g{(const bf16_t*)(ws + WS_YB), (const bf16_t*)(ws + WS_WB), MP, 1024, 512, 512}; pg8::StaticOrder S; S.init(MP, 1024, G, bid);
      pg8::EpiF8P<FGateB8> E{FGateB8{Zb, (const bf16_t*)hres, RA}};
      pg8::gemm_phase<pg8::EpiF8P<FGateB8>, pg8::StaticOrder, true, true>(lds, g, S, E);
      skinny_sample_gemm<512>((const bf16_t*)(ws + WS_YB) + (size_t)MP * 512, (const bf16_t*)(ws + WS_WB), bid, G, lane, wave, FGateB1{Zb, (const bf16_t*)hres, RA}); }
    }
    GSYNC();

    { PH_IDS();
    { pg8::Gemm g{RA, (const bf16_t*)(ws + WS_WMO), MP, 1024, 1024, 1024}; pg8::StaticOrder S; S.init(MP, 1024, G, bid);
      pg8::EpiF8P<FResX8> E{FResX8{p.in[0], hres}};
      pg8::gemm_phase<pg8::EpiF8P<FResX8>, pg8::StaticOrder, true, true>(lds, g, S, E);
      skinny_sample_gemm<1024>(RA + (size_t)MP * 1024, (const bf16_t*)(ws + WS_WMO), bid, G, lane, wave, FResX1{p.in[1], hres}); }
    }
    GSYNC();

    { PH_IDS();
    rms_pass<false>(p, p.in[20], gw, NGW, lane);
    }
    GSYNC();

    { PH_IDS();
    { pg8::Gemm g{RA, (const bf16_t*)(ws + WS_WXQ), MT, 512, 1024, 1024}; pg8::StaticOrder S; S.init(MT, 512, G, bid);
      pg8::EpiBf16 E{(bf16_t*)(ws + WS_Z + ZO_HQ), 512};
      pg8::gemm_phase<pg8::EpiBf16, pg8::StaticOrder, true, true>(lds, g, S, E); }
    const int tb0 = (G > 200) ? 168 : 0;
    if (bid >= tb0) {
      LAS float* scr = (LAS float*)(lds + wave * 16384);
      constexpr int J9 = 16 * 176, J10 = 44 * 32;
      for (int it = (bid - tb0) * 8 + wave; it < J9 + J10; it += (G - tb0) * 8) {
          if (it < J9) transpose_item(p.in[26], 5632, 0, 1024, 5632, (bf16_t*)(ws + WS_WUP), 0, scr, it, lane);
          else transpose_item(p.in[28], 1024, 0, 2816, 1024, (bf16_t*)(ws + WS_WDN), 0, scr, it - J9, lane); }
    }
    if (bid >= 136) {
      pg8::Gemm g{(const bf16_t*)(ws + WS_MEMN), (const bf16_t*)(ws + WS_WXKV), 2048, 1024, 1024, 1024}; pg8::StaticOrder S; S.init(2048, 1024, G - 136, bid - 136);
      pg8::EpiF<FMem> E{FMem{p.out + O_PMK, p.out + O_PMV}};
      pg8::gemm_phase<pg8::EpiF<FMem>, pg8::StaticOrder, true, true>(lds, g, S, E); }
    }
    GSYNC();

    { PH_IDS();
    {
        for (int it = bid; it < 256; it += G) { const int xcd = it & 7, slot = it >> 3, bh_ = xcd * 4 + (slot >> 3), qblk = slot & 7, h = bh_ & 3, b = bh_ >> 2;
            xattn_stage(lds, p.out + O_PMK + (size_t)b * 256 * 512, p.out + O_PMV + (size_t)b * 256 * 512, h, tid);
            LBAR();
            xattn_wave<2>(p, lds, b * 2048 + qblk * 256 + 32 * wave, 16, h, lane);
            LBAR(); }
        for (int it = bid; it < 512; it += G) { const int h = it & 3, s = it >> 2;
            xattn_stage(lds, p.in[7] + (size_t)s * 256 * 512, p.in[8] + (size_t)s * 256 * 512, h, tid);
            LBAR();
            if (wave == 0) xattn_wave<1>(p, lds, MP + 4 * s, 4, h, lane);
            LBAR(); }
    }
    }
    GSYNC();

    { PH_IDS();
    { pg8::Gemm g{(const bf16_t*)(ws + WS_Z + ZO_XO), (const bf16_t*)(ws + WS_WXO), MP, 1024, 512, 512}; pg8::StaticOrder S; S.init(MP, 1024, G, bid);
      pg8::EpiF8P<FAcc8> E{FAcc8{hres}};
      pg8::gemm_phase<pg8::EpiF8P<FAcc8>, pg8::StaticOrder, true, true>(lds, g, S, E);
      skinny_sample_gemm<512>((const bf16_t*)(ws + WS_Z + ZO_XO) + (size_t)MP * 512, (const bf16_t*)(ws + WS_WXO), bid, G, lane, wave, FAcc1{hres}); }
    }
    GSYNC();

    { PH_IDS();
    rms_pass<false>(p, p.in[25], gw, NGW, lane);
    }
    GSYNC();

    { PH_IDS();
    { pg8::Gemm g{RA, (const bf16_t*)(ws + WS_WUP), MT, 5632, 1024, 1024}; pg8::StaticOrder S; S.init(MT, 5632, G, bid);
      pg8::EpiBf16 E{(bf16_t*)(ws + WS_Z + ZO_UG), 5632};
      pg8::gemm_phase<pg8::EpiBf16, pg8::StaticOrder, true, true>(lds, g, S, E); }
    GSYNC();
    ffn_gate_chunk(p, 0, MT, gtid, GT);
    GSYNC();
    { pg8::Gemm g{(const bf16_t*)(ws + WS_Z + ZO_UG) + 2816, (const bf16_t*)(ws + WS_WDN), MP, 1024, 2816, 5632, 2816}; pg8::StaticOrder S; S.init(MP, 1024, G, bid);
      pg8::EpiF8P<FAcc8> E{FAcc8{hres}};
      pg8::gemm_phase<pg8::EpiF8P<FAcc8>, pg8::StaticOrder, true, true>(lds, g, S, E); }
    skinny_sample_gemm<2816, FAcc1, 5632>((const bf16_t*)(ws + WS_Z + ZO_UG) + 2816 + (size_t)MP * 5632, (const bf16_t*)(ws + WS_WDN), bid, G, lane, wave, FAcc1{hres});
    }
    GSYNC();

    { PH_IDS();
    rms_pass<true>(p, p.in[29], gw, NGW, lane);
    }
    if (p.ws == nullptr) grid.sync();
}


extern "C" void kernel_launch(void* const* d_in, const int* in_sizes, int n_in, void* d_out, int out_size, void* d_ws, size_t ws_size, hipStream_t stream) {
    static int grid = 0;
    if (grid == 0) {
        if (n_in != 30 || (size_t)out_size != O_END || ws_size < WS_END) { fprintf(stderr, "kernel_launch: unexpected shapes (n_in %d, out %d, ws %zu, need %zu)\n", n_in, out_size, ws_size, (size_t)WS_END); grid = -1; return; }
        int dev = 0, cus = 0, per_cu = 0;
        (void)hipGetDevice(&dev);
        (void)hipDeviceGetAttribute(&cus, hipDeviceAttributeMultiprocessorCount, dev);
        (void)hipFuncSetAttribute((const void*)mega_fwd, hipFuncAttributeMaxDynamicSharedMemorySize, LDS_BYTES);
        if (hipOccupancyMaxActiveBlocksPerMultiprocessor(&per_cu, (const void*)mega_fwd, NTHR, LDS_BYTES) != hipSuccess || per_cu < 1) { fprintf(stderr, "kernel_launch: occupancy query says %d\n", per_cu); per_cu = 1; }
        (void)hipGetLastError();
        grid = cus * 1;
        if (grid <= 0) grid = 256;
    }
    if (grid < 0) return;
    Params p{};
    for (int i = 0; i < 30; ++i) p.in[i] = (const float*)d_in[i];
    p.out = (float*)d_out; p.ws = (unsigned char*)d_ws;
    for (int i = 0; i < 8; ++i) p.inv[i] = pow(500000.0, -(double)i / 8.0);
    (void)hipMemsetAsync((char*)d_ws + WS_CTL, 0, 16384, stream);
    void* args[] = {&p};
    hipError_t e = hipLaunchCooperativeKernel((void*)mega_fwd, dim3(grid), dim3(NTHR), args, LDS_BYTES, stream);
    if (e != hipSuccess) fprintf(stderr, "cooperative launch failed: %s (grid %d)\n", hipGetErrorString(e), grid);
}
```
